# Optimizing an MI355X kernel written in HIP

```python
import jax, jax.numpy as jnp
from jax import lax
import numpy as np

D_MODEL = 1024
BATCH = 4
SEQ = 8192
DEPTH = 2

CHUNK = 64
Q_BLOCK = 128
D_FF = 2816
BRANCH_WIDTH = 512
N_BRANCH = 3
LRU_WIDTH = BRANCH_WIDTH
LRU_BLOCKS = 8
LRU_BLOCK = LRU_WIDTH // LRU_BLOCKS
CONV_WIDTH = 4
LRU_C = 8.0
GLA_HEADS = 4
GLA_DV = BRANCH_WIDTH // GLA_HEADS
GLA_DK = GLA_DV // 2
GLA_LOWRANK = 16
GLA_TAU = 16.0
FOX_HEADS = 8
FOX_DH = BRANCH_WIDTH // FOX_HEADS
PLE_DIM = 256
LN_EPS = 1e-5
RMS_EPS = 1e-6
DEEPNORM_ALPHA = (2 * DEPTH) ** 0.25
DEEPNORM_BETA = (8 * DEPTH) ** -0.25

SPLIT_SIZES = (
    LRU_WIDTH,
    LRU_WIDTH,
    GLA_HEADS * GLA_DK,
    GLA_HEADS * GLA_DK,
    GLA_HEADS * GLA_DV,
    GLA_LOWRANK,
    GLA_HEADS * GLA_DV,
    FOX_HEADS * FOX_DH,
    FOX_HEADS * FOX_DH,
    FOX_HEADS * FOX_DH,
    FOX_HEADS,
    N_BRANCH * D_MODEL,
)
SPLIT_POINTS = tuple(int(v) for v in np.cumsum(SPLIT_SIZES)[:-1])
D_IN = int(sum(SPLIT_SIZES))

kernel_name = 'hybrid_rglru_gla_fox_macaron_deepnorm'


def layer_norm(x, g, b):
    xf = x.astype(jnp.float32)
    mu = jnp.mean(xf, axis=-1, keepdims=True)
    var = jnp.mean(jnp.square(xf - mu), axis=-1, keepdims=True)
    y = (xf - mu) * lax.rsqrt(var + LN_EPS) * g.astype(jnp.float32) + b.astype(jnp.float32)
    return y.astype(x.dtype)


def swiglu(x, w_up, w_down):
    gate, up = jnp.split(x @ w_up, 2, axis=-1)
    return (jax.nn.silu(gate) * up) @ w_down


def linear_scan(a, b):
    def combine(left, right):
        return (left[0] * right[0], right[0] * left[1] + right[1])
    return lax.associative_scan(combine, (a, b), axis=1)[1]


def causal_depthwise_conv(x, w, b):
    y = lax.conv_general_dilated(
        x, w[:, None, :], window_strides=(1,), padding=[(CONV_WIDTH - 1, 0)],
        dimension_numbers=('NWC', 'WIO', 'NWC'), feature_group_count=x.shape[-1])
    return y + b


def rg_lru(x, wa, ba, wx, bx, lam):
    bsz, seq, width = x.shape
    f32 = jnp.float32
    xf = x.astype(f32)
    xb = xf.reshape(bsz, seq, LRU_BLOCKS, LRU_BLOCK)
    r = jax.nn.sigmoid(jnp.einsum('bsnc,ncd->bsnd', xb, wa.astype(f32)).reshape(bsz, seq, width) + ba.astype(f32))
    i = jax.nn.sigmoid(jnp.einsum('bsnc,ncd->bsnd', xb, wx.astype(f32)).reshape(bsz, seq, width) + bx.astype(f32))
    log_a = -LRU_C * r * jax.nn.softplus(-lam.astype(f32))
    a = jnp.exp(log_a)
    mult = jnp.sqrt(-jnp.expm1(2.0 * log_a))
    h = linear_scan(a, mult * (i * xf))
    return h.astype(x.dtype)


def gla(q, k, v, g_low, w_g2, b_g, norm_g, out_gate):
    bsz, seq, _ = q.shape
    nc = seq // CHUNK
    f32 = jnp.float32
    qc = q.astype(f32).reshape(bsz, nc, CHUNK, GLA_HEADS, GLA_DK) * (GLA_DK ** -0.5)
    kc = k.astype(f32).reshape(bsz, nc, CHUNK, GLA_HEADS, GLA_DK)
    vc = v.astype(f32).reshape(bsz, nc, CHUNK, GLA_HEADS, GLA_DV)
    log_alpha = jax.nn.log_sigmoid((g_low @ w_g2 + b_g).astype(f32)) / GLA_TAU
    log_alpha = log_alpha.reshape(bsz, nc, CHUNK, GLA_HEADS, GLA_DK)
    g_cum = jnp.cumsum(log_alpha, axis=2)
    g_tot = g_cum[:, :, -1]
    k_dec = kc * jnp.exp(g_tot[:, :, None] - g_cum)
    delta = jnp.einsum('bnchk,bnchv->bnhkv', k_dec, vc)
    state = linear_scan(jnp.exp(g_tot)[..., None], delta)
    o = jnp.einsum('bnchk,bnhkv->bnchv', qc, state)
    o = o * lax.rsqrt(jnp.mean(jnp.square(o), axis=-1, keepdims=True) + RMS_EPS)
    o = o.reshape(bsz, seq, GLA_HEADS * GLA_DV) * norm_g.astype(f32)
    return o.astype(q.dtype) * jax.nn.silu(out_gate)


def forgetting_attention(q, k, v, f_logit, b_f):
    bsz, seq, _ = q.shape
    nb = seq // Q_BLOCK
    f32 = jnp.float32
    scale = FOX_DH ** -0.5
    qh = q.reshape(bsz, seq, FOX_HEADS, FOX_DH)
    kh = k.reshape(bsz, seq, FOX_HEADS, FOX_DH).transpose(0, 2, 1, 3)
    vh = v.reshape(bsz, seq, FOX_HEADS, FOX_DH).transpose(0, 2, 1, 3)
    log_f = jax.nn.log_sigmoid((f_logit + b_f).astype(f32))
    f_cum = jnp.cumsum(log_f, axis=1).transpose(0, 2, 1)
    q_blk = qh.reshape(bsz, nb, Q_BLOCK, FOX_HEADS, FOX_DH).transpose(1, 0, 3, 2, 4)
    f_blk = f_cum.reshape(bsz, FOX_HEADS, nb, Q_BLOCK).transpose(2, 0, 1, 3)
    kpos = jnp.arange(seq)

    def attend(args):
        qb, fb, n = args
        logits = jnp.einsum('bhqd,bhkd->bhqk', qb, kh).astype(f32) * scale
        logits = logits + (fb[..., None] - f_cum[:, :, None, :])
        qpos = n * Q_BLOCK + jnp.arange(Q_BLOCK)
        mask = kpos[None, :] <= qpos[:, None]
        probs = jax.nn.softmax(jnp.where(mask, logits, -jnp.inf), axis=-1)
        return jnp.einsum('bhqk,bhkd->bhqd', probs.astype(vh.dtype), vh)

    out = lax.map(attend, (q_blk, f_blk, jnp.arange(nb)))
    return out.transpose(1, 0, 3, 2, 4).reshape(bsz, seq, FOX_HEADS * FOX_DH)


def hybrid_mixer(x, w_in, conv_w, conv_b, lru_wa, lru_ba, lru_wx, lru_bx, lru_lambda,
                 gla_w_g2, gla_b_g, gla_norm_g, fox_b_f, w_branch, w_out):
    bsz, seq, _ = x.shape
    (a_x, a_y, b_q, b_k, b_v, b_low, b_r,
     c_q, c_k, c_v, c_f, gate_logits) = jnp.split(x @ w_in, SPLIT_POINTS, axis=-1)
    y_a = jax.nn.gelu(a_y) * rg_lru(causal_depthwise_conv(a_x, conv_w, conv_b),
                                    lru_wa, lru_ba, lru_wx, lru_bx, lru_lambda)
    y_b = gla(b_q, b_k, b_v, b_low, gla_w_g2, gla_b_g, gla_norm_g, b_r)
    y_c = forgetting_attention(c_q, c_k, c_v, c_f, fox_b_f)
    gates = jax.nn.sigmoid(gate_logits).reshape(bsz, seq, N_BRANCH, D_MODEL)
    merged = (gates[:, :, 0] * (y_a @ w_branch[0])
              + gates[:, :, 1] * (y_b @ w_branch[1])
              + gates[:, :, 2] * (y_c @ w_branch[2]))
    return merged @ w_out


def setup_inputs(seed: int = 0) -> dict:
    key = jax.random.key(seed)
    ks = jax.random.split(key, 40)
    f32 = jnp.float32

    def nrm(k, shape, scale):
        return jax.random.normal(k, shape, f32) * scale

    def gain(k, shape):
        return 1.0 + 0.02 * jax.random.normal(k, shape, f32)

    u = jax.random.uniform(ks[12], (DEPTH, LRU_WIDTH), f32, minval=0.9, maxval=0.999)
    a0 = u ** (1.0 / LRU_C)
    lru_lambda = jnp.log(a0) - jnp.log1p(-a0)

    return {
        'x': nrm(ks[0], (BATCH, SEQ, D_MODEL), 1.0),
        'p': nrm(ks[1], (DEPTH, BATCH, SEQ, PLE_DIM), 1.0),
        'ffn1_w_up': nrm(ks[2], (DEPTH, D_MODEL, 2 * D_FF), D_MODEL ** -0.5),
        'ffn1_w_down': nrm(ks[3], (DEPTH, D_FF, D_MODEL), D_FF ** -0.5 * DEEPNORM_BETA),
        'ln1_g': gain(ks[4], (DEPTH, D_MODEL)),
        'ln1_b': nrm(ks[5], (DEPTH, D_MODEL), 0.02),
        'w_in': nrm(ks[6], (DEPTH, D_MODEL, D_IN), D_MODEL ** -0.5),
        'conv_w': nrm(ks[7], (DEPTH, CONV_WIDTH, LRU_WIDTH), CONV_WIDTH ** -0.5),
        'conv_b': nrm(ks[8], (DEPTH, LRU_WIDTH), 0.02),
        'lru_wa': nrm(ks[9], (DEPTH, LRU_BLOCKS, LRU_BLOCK, LRU_BLOCK), LRU_BLOCK ** -0.5),
        'lru_ba': nrm(ks[10], (DEPTH, LRU_WIDTH), 0.02),
        'lru_wx': nrm(ks[11], (DEPTH, LRU_BLOCKS, LRU_BLOCK, LRU_BLOCK), LRU_BLOCK ** -0.5),
        'lru_bx': nrm(ks[13], (DEPTH, LRU_WIDTH), 0.02),
        'lru_lambda': lru_lambda,
        'gla_w_g2': nrm(ks[14], (DEPTH, GLA_LOWRANK, GLA_HEADS * GLA_DK), GLA_LOWRANK ** -0.5),
        'gla_b_g': nrm(ks[15], (DEPTH, GLA_HEADS * GLA_DK), 0.02),
        'gla_norm_g': gain(ks[16], (DEPTH, GLA_HEADS * GLA_DV)),
        'fox_b_f': jax.random.uniform(ks[17], (DEPTH, FOX_HEADS), f32, minval=1.0, maxval=4.0),
        'w_branch': nrm(ks[18], (DEPTH, N_BRANCH, BRANCH_WIDTH, D_MODEL), BRANCH_WIDTH ** -0.5),
        'w_out': nrm(ks[19], (DEPTH, D_MODEL, D_MODEL), D_MODEL ** -0.5 * DEEPNORM_BETA),
        'ln2_g': gain(ks[20], (DEPTH, D_MODEL)),
        'ln2_b': nrm(ks[21], (DEPTH, D_MODEL), 0.02),
        'ffn2_w_up': nrm(ks[22], (DEPTH, D_MODEL, 2 * D_FF), D_MODEL ** -0.5),
        'ffn2_w_down': nrm(ks[23], (DEPTH, D_FF, D_MODEL), D_FF ** -0.5 * DEEPNORM_BETA),
        'ln3_g': gain(ks[24], (DEPTH, D_MODEL)),
        'ln3_b': nrm(ks[25], (DEPTH, D_MODEL), 0.02),
        'ple_w_proj': nrm(ks[26], (DEPTH, PLE_DIM, D_MODEL), PLE_DIM ** -0.5 * DEEPNORM_BETA),
        'ple_w_gate': nrm(ks[27], (DEPTH, D_MODEL, D_MODEL), D_MODEL ** -0.5),
        'ple_b_gate': nrm(ks[28], (DEPTH, D_MODEL), 0.02),
        'ln4_g': gain(ks[29], (DEPTH, D_MODEL)),
        'ln4_b': nrm(ks[30], (DEPTH, D_MODEL), 0.02),
    }


def reference(x, p, ffn1_w_up, ffn1_w_down, ln1_g, ln1_b, w_in, conv_w, conv_b,
              lru_wa, lru_ba, lru_wx, lru_bx, lru_lambda, gla_w_g2, gla_b_g, gla_norm_g,
              fox_b_f, w_branch, w_out, ln2_g, ln2_b, ffn2_w_up, ffn2_w_down, ln3_g, ln3_b,
              ple_w_proj, ple_w_gate, ple_b_gate, ln4_g, ln4_b):
    for i in range(DEPTH):
        x = layer_norm(DEEPNORM_ALPHA * x + 0.5 * swiglu(x, ffn1_w_up[i], ffn1_w_down[i]),
                       ln1_g[i], ln1_b[i])
        mix = hybrid_mixer(x, w_in[i], conv_w[i], conv_b[i], lru_wa[i], lru_ba[i], lru_wx[i],
                           lru_bx[i], lru_lambda[i], gla_w_g2[i], gla_b_g[i], gla_norm_g[i],
                           fox_b_f[i], w_branch[i], w_out[i])
        x = layer_norm(DEEPNORM_ALPHA * x + mix, ln2_g[i], ln2_b[i])
        x = layer_norm(DEEPNORM_ALPHA * x + 0.5 * swiglu(x, ffn2_w_up[i], ffn2_w_down[i]),
                       ln3_g[i], ln3_b[i])
        pe = p[i] @ ple_w_proj[i]
        x = layer_norm(DEEPNORM_ALPHA * x + jax.nn.sigmoid(x @ ple_w_gate[i] + ple_b_gate[i]) * pe,
                       ln4_g[i], ln4_b[i])
    return x
```

```cpp
#define MK_MULTI 0
#include <hip/hip_runtime.h>
#include <hip/hip_cooperative_groups.h>
namespace cg = cooperative_groups;
#include <cstdio>
#include <cstdint>
namespace pg8 {
#define PG8_LAS __attribute__((address_space(3)))
typedef unsigned short bf16_t;
typedef short bf16x8 __attribute__((ext_vector_type(8)));
typedef float f32x4 __attribute__((ext_vector_type(4)));
typedef unsigned u32x4 __attribute__((ext_vector_type(4)));
constexpr int BM = 256, BK = 64, HALF = 128, HTB = HALF * BK * 2  , STAGE_BYTES = 8 * HTB, NXCD = 8, WGM = 8;

__host__ __device__ __forceinline__ int lds_byte(int r, int c) { const int st = (r >> 4) * 2 + (c >> 5), rr = r & 15, cc = c & 31, ob = rr * 64 + cc * 2; return st * 1024 + (ob ^ (((ob >> 9) & 1) << 5)); }
__host__ __device__ __forceinline__ void stage_rc(int b, int& R, int& C) { const int st = b / 1024, sb = b % 1024, swz = sb ^ (((sb >> 9) & 1) << 5); R = (st >> 1) * 16 + swz / 64; C = (st & 1) * 32 + (swz % 64) / 2; }
__host__ __device__ __forceinline__ int perm32(int rho) { const int n = rho >> 4, i = rho & 15; return 8 * (i >> 2) + 4 * n + (i & 3); }

struct Unit { int pm, pn; };
struct Gemm { const bf16_t* A; const bf16_t* Bt; int M, N, K; };

struct StaticOrder {
    int nM, nN, nwg, G, c;
    __host__ __device__ void init(int M, int N, int G_, int c_) { nM = M / BM; nN = N / BM; nwg = nM * nN; G = G_; c = c_; }
    __host__ __device__ bool next(int i, Unit& u) const {
        const int L = i * G + c; if (L >= nwg) return false;
        int wgid = (int)L; { const int q = nwg / NXCD, r = nwg % NXCD, xcd = wgid % NXCD, off = wgid / NXCD; wgid = (xcd < r ? xcd * (q + 1) : r * (q + 1) + (xcd - r) * q) + off; }
        const int nig = WGM * nN, gid = wgid / nig, fm = gid * WGM, gsz = (nM - fm) < WGM ? (nM - fm) : WGM;
        u.pm = fm + ((wgid % nig) % gsz); u.pn = (wgid % nig) / gsz; return true;
    }
    __device__ __forceinline__ void a_ready(const Unit&) const {}
    __device__ __forceinline__ void done(const Unit&) const {}
};

typedef float cvf2_t __attribute__((ext_vector_type(2))); typedef __bf16 cvb2_t __attribute__((ext_vector_type(2)));
__device__ __forceinline__ unsigned cvt_pk_bf16(float lo, float hi) { const cvf2_t v = {lo, hi}; const cvb2_t b = __builtin_convertvector(v, cvb2_t); return __builtin_bit_cast(unsigned, b); }
typedef float f32x2 __attribute__((ext_vector_type(2)));
__device__ __forceinline__ f32x2 gelu_pk(f32x2 v) {
    const f32x2 av = __builtin_elementwise_abs(v), d = av * 0.2316418882f + 1.0f;
    f32x2 t; t.x = __builtin_amdgcn_rcpf(d.x); t.y = __builtin_amdgcn_rcpf(d.y);
    f32x2 q = t * 0.5307027145f + (-0.7265760135f); q = q * t + 0.7107068705f; q = q * t + (-0.142248368f); q = q * t + 0.127414796f; q = q * t;
    const f32x2 s = (v * v) * (-0.72134752044f);
    f32x2 e; e.x = __builtin_amdgcn_exp2f(s.x); e.y = __builtin_amdgcn_exp2f(s.y);
    const f32x2 m = v * (q * e), r = v - m;
    f32x2 o; o.x = v.x < 0.f ? m.x : r.x; o.y = v.y < 0.f ? m.y : r.y; return o;
}

template <int ACT  > struct EpiBf16 {
    static constexpr bool PERM = true, AFTER_DRAIN = false; static_assert(ACT == 0 || ACT == 1, "EpiBf16: ACT is 0 (none) or 1 (gelu_pk)");
    bf16_t* O; int ldc; const float* bias; int split_cols; size_t split_stride; float scale0;
    __device__ __forceinline__ void operator()(const f32x4 (&acc)[2][2][4][2], const Unit& u, int wr, int wc, int fr, int fq) const {
        const int row0 = u.pm * BM + wr * 64 + fr; int colt = u.pn * BM; bf16_t* base = O;
        float sc = 1.f; if (split_cols) { const int t = colt / split_cols; base += (size_t)t * split_stride; colt -= t * split_cols; if (t == 0) sc = scale0; }
        const int col0 = colt + wc * 32 + 8 * fq, bcol0 = u.pn * BM + wc * 32 + 8 * fq;
        f32x4 bv[2][2];
#pragma unroll
        for (int bj = 0; bj < 2; ++bj)
#pragma unroll
            for (int n = 0; n < 2; ++n) bv[bj][n] = bias ? *(const f32x4*)(bias + bcol0 + bj * HALF + 4 * n) : (f32x4){0.f, 0.f, 0.f, 0.f};
#pragma unroll
        for (int ai = 0; ai < 2; ++ai)
#pragma unroll
            for (int m = 0; m < 4; ++m) { bf16_t* rowp = base + (size_t)(row0 + ai * HALF + m * 16) * ldc + col0;
#pragma unroll
                for (int bj = 0; bj < 2; ++bj) { f32x4 v0 = acc[ai][bj][m][0] + bv[bj][0], v1 = acc[ai][bj][m][1] + bv[bj][1];
                    if (ACT == 1) { f32x2 a = gelu_pk((f32x2){v0[0], v0[1]}), b = gelu_pk((f32x2){v0[2], v0[3]}), c = gelu_pk((f32x2){v1[0], v1[1]}), d = gelu_pk((f32x2){v1[2], v1[3]});
                        v0 = (f32x4){a.x, a.y, b.x, b.y}; v1 = (f32x4){c.x, c.y, d.x, d.y}; }
                    v0 = v0 * sc; v1 = v1 * sc; u32x4 w; w.x = cvt_pk_bf16(v0[0], v0[1]); w.y = cvt_pk_bf16(v0[2], v0[3]); w.z = cvt_pk_bf16(v1[0], v1[1]); w.w = cvt_pk_bf16(v1[2], v1[3]);
                    *(u32x4*)(rowp + bj * HALF) = w; } }
    }
};

constexpr float MK_ALPHA = 1.41421356237309515f;
__device__ __forceinline__ float sigm(float x) { return __builtin_amdgcn_rcpf(1.0f + __builtin_amdgcn_exp2f(-1.4426950408889634f * x)); }
__device__ __forceinline__ float bf2f(unsigned short h) { return __uint_as_float(((unsigned)h) << 16); }
struct EpiSwiglu {
    static constexpr bool PERM = true, AFTER_DRAIN = false;
    bf16_t* H; int ldh;
    __device__ __forceinline__ void operator()(const f32x4 (&acc)[2][2][4][2], const Unit& u, int wr, int wc, int fr, int fq) const {
        const int row0 = u.pm * BM + wr * 64 + fr, col0 = u.pn * HALF + wc * 32 + 8 * fq;
#pragma unroll
        for (int ai = 0; ai < 2; ++ai)
#pragma unroll
            for (int m = 0; m < 4; ++m) { bf16_t* rowp = H + (size_t)(row0 + ai * HALF + m * 16) * ldh + col0;
                float h[8];
#pragma unroll
                for (int n = 0; n < 2; ++n)
#pragma unroll
                    for (int i = 0; i < 4; ++i) { const float g = acc[ai][0][m][n][i], up = acc[ai][1][m][n][i]; h[4 * n + i] = g * sigm(g) * up; }
                u32x4 w; w.x = cvt_pk_bf16(h[0], h[1]); w.y = cvt_pk_bf16(h[2], h[3]); w.z = cvt_pk_bf16(h[4], h[5]); w.w = cvt_pk_bf16(h[6], h[7]);
                *(u32x4*)rowp = w; }
    }
};
struct EpiResid {
    static constexpr bool PERM = true, AFTER_DRAIN = false;
    float* X; float s;
    __device__ __forceinline__ void operator()(const f32x4 (&acc)[2][2][4][2], const Unit& u, int wr, int wc, int fr, int fq) const {
        const int row0 = u.pm * BM + wr * 64 + fr, col0 = u.pn * BM + wc * 32 + 8 * fq;
#pragma unroll
        for (int ai = 0; ai < 2; ++ai)
#pragma unroll
            for (int m = 0; m < 4; ++m) { float* rowp = X + (size_t)(row0 + ai * HALF + m * 16) * 1024 + col0;
#pragma unroll
                for (int bj = 0; bj < 2; ++bj)
#pragma unroll
                    for (int n = 0; n < 2; ++n) { f32x4* p = (f32x4*)(rowp + bj * HALF + 4 * n); const f32x4 v = *p; *p = v * MK_ALPHA + acc[ai][bj][m][n] * s; } }
    }
};
struct EpiMixIn {
    static constexpr bool PERM = true, AFTER_DRAIN = false;
    bf16_t* big; float* low; float* fl; float cq_scale;
    __device__ __forceinline__ void operator()(const f32x4 (&acc)[2][2][4][2], const Unit& u, int wr, int wc, int fr, int fq) const {
        const int pn = u.pn; const int row0 = u.pm * BM + wr * 64 + fr;
        if (pn < 16) {
            size_t off; int ld, co; float sc = 1.f;
            if (pn < 2)       { off = 0;                  ld = 512; co = pn * 256; }
            else if (pn < 4)  { off = (size_t)32 << 20;   ld = 512; co = (pn - 2) * 256; }
            else if (pn == 4) { off = (size_t)16 << 20;   ld = 256; co = 0; sc = 0.125f; }
            else if (pn == 5) { off = (size_t)24 << 20;   ld = 256; co = 0; }
            else if (pn < 8)  { off = (size_t)48 << 20;   ld = 512; co = (pn - 6) * 256; }
            else if (pn < 10) { off = (size_t)64 << 20;   ld = 512; co = (pn - 8) * 256; }
            else if (pn < 12) { off = (size_t)80 << 20;   ld = 512; co = (pn - 10) * 256; sc = cq_scale; }
            else if (pn < 14) { off = (size_t)96 << 20;   ld = 512; co = (pn - 12) * 256; }
            else              { off = (size_t)112 << 20;  ld = 512; co = (pn - 14) * 256; }
            bf16_t* base = big + off; const int col0 = co + wc * 32 + 8 * fq;
#pragma unroll
            for (int ai = 0; ai < 2; ++ai)
#pragma unroll
                for (int m = 0; m < 4; ++m) { bf16_t* rowp = base + (size_t)(row0 + ai * HALF + m * 16) * ld + col0;
#pragma unroll
                    for (int bj = 0; bj < 2; ++bj) { const f32x4 v0 = acc[ai][bj][m][0] * sc, v1 = acc[ai][bj][m][1] * sc;
                        u32x4 w; w.x = cvt_pk_bf16(v0[0], v0[1]); w.y = cvt_pk_bf16(v0[2], v0[3]); w.z = cvt_pk_bf16(v1[0], v1[1]); w.w = cvt_pk_bf16(v1[2], v1[3]);
                        *(u32x4*)(rowp + bj * HALF) = w; } }
        } else {
            if (wc == 0 && fq < 3) {
#pragma unroll
                for (int ai = 0; ai < 2; ++ai)
#pragma unroll
                    for (int m = 0; m < 4; ++m) { const size_t row = (size_t)(row0 + ai * HALF + m * 16);
                        float* dst = (fq < 2) ? (low + row * 16 + 8 * fq) : (fl + row * 8);
                        *(f32x4*)dst = acc[ai][0][m][0]; *(f32x4*)(dst + 4) = acc[ai][0][m][1]; }
            }
        }
    }
};
struct EpiSig {
    static constexpr bool PERM = true, AFTER_DRAIN = false;
    bf16_t* S; const float* bias;
    __device__ __forceinline__ void operator()(const f32x4 (&acc)[2][2][4][2], const Unit& u, int wr, int wc, int fr, int fq) const {
        const int row0 = u.pm * BM + wr * 64 + fr, col0 = u.pn * BM + wc * 32 + 8 * fq;
        f32x4 bv[2][2];
#pragma unroll
        for (int bj = 0; bj < 2; ++bj)
#pragma unroll
            for (int n = 0; n < 2; ++n) bv[bj][n] = bias ? *(const f32x4*)(bias + col0 + bj * HALF + 4 * n) : (f32x4){0.f, 0.f, 0.f, 0.f};
#pragma unroll
        for (int ai = 0; ai < 2; ++ai)
#pragma unroll
            for (int m = 0; m < 4; ++m) { bf16_t* rowp = S + (size_t)(row0 + ai * HALF + m * 16) * 1024 + col0;
#pragma unroll
                for (int bj = 0; bj < 2; ++bj) { const f32x4 v0 = acc[ai][bj][m][0] + bv[bj][0], v1 = acc[ai][bj][m][1] + bv[bj][1];
                    u32x4 w; w.x = cvt_pk_bf16(sigm(v0[0]), sigm(v0[1])); w.y = cvt_pk_bf16(sigm(v0[2]), sigm(v0[3])); w.z = cvt_pk_bf16(sigm(v1[0]), sigm(v1[1])); w.w = cvt_pk_bf16(sigm(v1[2]), sigm(v1[3]));
                    *(u32x4*)(rowp + bj * HALF) = w; } }
    }
};
struct EpiGateMul {
    static constexpr bool PERM = true, AFTER_DRAIN = false;
    const bf16_t* S; bf16_t* P; int first;
    __device__ __forceinline__ void operator()(const f32x4 (&acc)[2][2][4][2], const Unit& u, int wr, int wc, int fr, int fq) const {
        const int row0 = u.pm * BM + wr * 64 + fr, col0 = u.pn * BM + wc * 32 + 8 * fq;
#pragma unroll
        for (int ai = 0; ai < 2; ++ai)
#pragma unroll
            for (int m = 0; m < 4; ++m) { const size_t ro = (size_t)(row0 + ai * HALF + m * 16) * 1024 + col0;
#pragma unroll
                for (int bj = 0; bj < 2; ++bj) { const u32x4 sv = *(const u32x4*)(S + ro + bj * HALF); u32x4 pv = (u32x4){0u, 0u, 0u, 0u}; if (!first) pv = *(const u32x4*)(P + ro + bj * HALF);
                    float o[8];
#pragma unroll
                    for (int i = 0; i < 4; ++i) {
#ifdef MK_DBG_NOS
                        const unsigned sw = 0x3f803f80u, pw = pv[i];
#else
                        const unsigned sw = sv[i], pw = pv[i];
#endif
 const float a0 = acc[ai][bj][m][i >> 1][(i & 1) * 2], a1 = acc[ai][bj][m][i >> 1][(i & 1) * 2 + 1];
                        o[2 * i] = __uint_as_float(pw << 16) + __uint_as_float(sw << 16) * a0; o[2 * i + 1] = __uint_as_float(pw & 0xffff0000u) + __uint_as_float(sw & 0xffff0000u) * a1; }
                    u32x4 w; w.x = cvt_pk_bf16(o[0], o[1]); w.y = cvt_pk_bf16(o[2], o[3]); w.z = cvt_pk_bf16(o[4], o[5]); w.w = cvt_pk_bf16(o[6], o[7]);
                    *(u32x4*)(P + ro + bj * HALF) = w; }
                asm volatile("" ::: "memory"); }
    }
};
struct EpiPle {
    static constexpr bool PERM = true, AFTER_DRAIN = false;
    const bf16_t* S; float* X;
    __device__ __forceinline__ void operator()(const f32x4 (&acc)[2][2][4][2], const Unit& u, int wr, int wc, int fr, int fq) const {
        const int row0 = u.pm * BM + wr * 64 + fr, col0 = u.pn * BM + wc * 32 + 8 * fq;
#pragma unroll
        for (int ai = 0; ai < 2; ++ai)
#pragma unroll
            for (int m = 0; m < 4; ++m) { const size_t ro = (size_t)(row0 + ai * HALF + m * 16) * 1024 + col0;
#pragma unroll
                for (int bj = 0; bj < 2; ++bj) { const u32x4 sv = *(const u32x4*)(S + ro + bj * HALF);
#pragma unroll
                    for (int n = 0; n < 2; ++n) { f32x4* p = (f32x4*)(X + ro + bj * HALF + 4 * n); const f32x4 v = *p; f32x4 g;
                        g[0] = __uint_as_float(sv[2 * n] << 16); g[1] = __uint_as_float(sv[2 * n] & 0xffff0000u); g[2] = __uint_as_float(sv[2 * n + 1] << 16); g[3] = __uint_as_float(sv[2 * n + 1] & 0xffff0000u);
                        *p = v * MK_ALPHA + g * acc[ai][bj][m][n]; } }
                asm volatile("" ::: "memory"); }
    }
};
template <class Epi, class Sched, bool ALIGN_EPI = false, bool SP2 = false>
__device__ __forceinline__ void gemm_phase(PG8_LAS unsigned char* lds, const Gemm g, const Sched& S, const Epi& E) {
    int tid_ = threadIdx.x; asm volatile("" : "+v"(tid_)); const int tid = tid_, wid = __builtin_amdgcn_readfirstlane(tid >> 6), lane = tid & 63, wr = wid >> 2, wc = wid & 3, fr = lane & 15, fq = lane >> 4;
    const int K = g.K, nt = K / BK;
    unsigned voffA[2], voffB[2];
#pragma unroll
    for (int i = 0; i < 2; ++i) { int R, C; stage_rc(tid * 16 + i * 8192, R, C); const int Rb = Epi::PERM ? ((R & ~31) + perm32(R & 31)) : R;
        voffA[i] = (unsigned)(R * K + C) * 2u; voffB[i] = (unsigned)(Rb * K + C) * 2u; }
    const size_t kstep = (size_t)(BK * 2);
    const size_t hstep = (size_t)HALF * K * 2;
    const size_t tstep = 2 * hstep;
    const unsigned ldsw = (unsigned)wid * 1024u;
    const int aoff = lds_byte(wr * 64 + fr, fq * 8), boff = lds_byte(wc * 32 + fr, fq * 8);
#define PG8_SA(b, h) (((b) * 2 + (h)) * HTB)
#define PG8_SB(b, h) ((4 + (b) * 2 + (h)) * HTB)
#define PG8_STAGE(bufoff, gbase, voff) do { _Pragma("unroll") for (int _i = 0; _i < 2; ++_i) \
        __builtin_amdgcn_global_load_lds((const unsigned*)((const char*)(gbase) + (voff)[_i]), (PG8_LAS unsigned*)(lds + (bufoff) + ldsw + _i * 8192), 16, 0, 0); } while (0)
#define PG8_LDA(dst, b, h) do { _Pragma("unroll") for (int m = 0; m < 4; ++m) _Pragma("unroll") for (int k = 0; k < 2; ++k) dst[m][k] = *(const PG8_LAS bf16x8*)(lds + PG8_SA(b, h) + aoff + m * 2048 + k * 1024); } while (0)
#define PG8_LDB(dst, b, h) do { _Pragma("unroll") for (int n = 0; n < 2; ++n) _Pragma("unroll") for (int k = 0; k < 2; ++k) dst[n][k] = *(const PG8_LAS bf16x8*)(lds + PG8_SB(b, h) + boff + n * 2048 + k * 1024); } while (0)
#define PG8_MMA(ai, bj, At, Bt) do { __builtin_amdgcn_s_setprio(1); _Pragma("unroll") for (int m = 0; m < 4; ++m) _Pragma("unroll") for (int n = 0; n < 2; ++n) _Pragma("unroll") for (int k = 0; k < 2; ++k) \
        acc[ai][bj][m][n] = __builtin_amdgcn_mfma_f32_16x16x32_bf16(Bt[n][k], At[m][k], acc[ai][bj][m][n], 0, 0, 0); __builtin_amdgcn_s_setprio(0); } while (0)
#define PG8_WAIT_V(n) asm volatile("s_waitcnt vmcnt(" #n ")" ::: "memory")
#define PG8_WAIT_L(n) asm volatile("s_waitcnt lgkmcnt(" #n ")" ::: "memory")
#define PG8_BAR __builtin_amdgcn_s_barrier()
#define PG8_SCHED __builtin_amdgcn_sched_barrier(0)
    Unit cur, nxt; int ui = 0;
    if (!S.next(0, cur)) return;
    f32x4 acc[2][2][4][2];
#pragma unroll
    for (int a = 0; a < 2; ++a)
#pragma unroll
        for (int b = 0; b < 2; ++b)
#pragma unroll
            for (int m = 0; m < 4; ++m)
#pragma unroll
                for (int n = 0; n < 2; ++n) acc[a][b][m][n] = (f32x4){0.f, 0.f, 0.f, 0.f};
    bf16x8 At[4][2], B0[2][2], B1[2][2];
    const char* cA = (const char*)g.A + (size_t)cur.pm * tstep; const char* cB = (const char*)g.Bt + (size_t)cur.pn * tstep;
    S.a_ready(cur);
    if constexpr (SP2) {
        PG8_STAGE(PG8_SB(0, 0), cB, voffB); PG8_STAGE(PG8_SB(0, 1), cB + hstep, voffB); PG8_STAGE(PG8_SA(0, 0), cA, voffA); PG8_STAGE(PG8_SA(0, 1), cA + hstep, voffA);
        if (wr == 1) PG8_BAR;
        PG8_WAIT_V(2); PG8_BAR;
        PG8_STAGE(PG8_SB(1, 0), cB + kstep, voffB); PG8_STAGE(PG8_SA(1, 0), cA + kstep, voffA); PG8_STAGE(PG8_SB(1, 1), cB + hstep + kstep, voffB);
        PG8_WAIT_V(6); PG8_BAR;
    } else {
        PG8_STAGE(PG8_SB(0, 0), cB, voffB); PG8_STAGE(PG8_SA(0, 0), cA, voffA); PG8_STAGE(PG8_SB(0, 1), cB + hstep, voffB); PG8_STAGE(PG8_SA(0, 1), cA + hstep, voffA);
        if (wr == 1) PG8_BAR;
        PG8_WAIT_V(4); PG8_BAR;
        PG8_STAGE(PG8_SB(1, 0), cB + kstep, voffB); PG8_STAGE(PG8_SA(1, 0), cA + kstep, voffA); PG8_STAGE(PG8_SB(1, 1), cB + hstep + kstep, voffB);
        PG8_WAIT_V(6); PG8_BAR;
    }
    for (;;) {
        const bool has_next = S.next(ui + 1, nxt);
        const char* nA = has_next ? (const char*)g.A + (size_t)nxt.pm * tstep : cA; const char* nB = has_next ? (const char*)g.Bt + (size_t)nxt.pn * tstep : cB;
        for (int t = 0; t < nt; t += 2) {
            const bool last = (t == nt - 2);
            const char* a1 = cA + (size_t)(t + 1) * kstep;
            const char* a2 = last ? nA : cA + (size_t)(t + 2) * kstep; const char* b2 = last ? nB : cB + (size_t)(t + 2) * kstep;
            const char* a3 = a2 + kstep; const char* b3 = b2 + kstep;
            if (last && has_next) S.a_ready(nxt);
            if constexpr (SP2) {
            PG8_LDB(B0, 0, 0); PG8_LDB(B1, 0, 1); PG8_SCHED; PG8_LDA(At, 0, 0); PG8_STAGE(PG8_SA(1, 1), a1 + hstep, voffA);
            PG8_WAIT_V(8); PG8_WAIT_L(0); PG8_BAR; PG8_MMA(0, 0, At, B0); PG8_MMA(0, 1, At, B1); PG8_BAR; PG8_SCHED;
            PG8_LDA(At, 0, 1); PG8_STAGE(PG8_SB(0, 0), b2, voffB); PG8_STAGE(PG8_SB(0, 1), b2 + hstep, voffB); PG8_STAGE(PG8_SA(0, 0), a2, voffA);
            PG8_WAIT_V(8); PG8_WAIT_L(0); PG8_BAR; PG8_MMA(1, 0, At, B0); PG8_MMA(1, 1, At, B1); PG8_BAR; PG8_SCHED;
            PG8_LDB(B0, 1, 0); PG8_LDB(B1, 1, 1); PG8_SCHED; PG8_LDA(At, 1, 0); PG8_STAGE(PG8_SA(0, 1), a2 + hstep, voffA);
            PG8_WAIT_V(8); PG8_WAIT_L(0); PG8_BAR; PG8_MMA(0, 0, At, B0); PG8_MMA(0, 1, At, B1); PG8_BAR; PG8_SCHED;
            PG8_LDA(At, 1, 1); PG8_STAGE(PG8_SB(1, 0), b3, voffB); PG8_STAGE(PG8_SB(1, 1), b3 + hstep, voffB); PG8_STAGE(PG8_SA(1, 0), a3, voffA);
            PG8_WAIT_V(8); PG8_WAIT_L(0); PG8_BAR; PG8_MMA(1, 0, At, B0); PG8_MMA(1, 1, At, B1); PG8_BAR; PG8_SCHED;
            } else {
            PG8_LDB(B0, 0, 0); PG8_SCHED; PG8_LDA(At, 0, 0); PG8_STAGE(PG8_SA(1, 1), a1 + hstep, voffA);
            PG8_WAIT_L(8); PG8_BAR; PG8_WAIT_L(0); PG8_MMA(0, 0, At, B0); PG8_BAR; PG8_SCHED;
            PG8_LDB(B1, 0, 1); PG8_STAGE(PG8_SB(0, 0), b2, voffB);
            PG8_BAR; PG8_WAIT_L(0); PG8_MMA(0, 1, At, B1); PG8_BAR;
            PG8_LDA(At, 0, 1); PG8_STAGE(PG8_SA(0, 0), a2, voffA);
            PG8_BAR; PG8_WAIT_L(0); PG8_MMA(1, 0, At, B0); PG8_BAR; PG8_SCHED;
            PG8_STAGE(PG8_SB(0, 1), b2 + hstep, voffB);
            PG8_WAIT_V(6); PG8_BAR; PG8_MMA(1, 1, At, B1); PG8_BAR;
            PG8_LDB(B0, 1, 0); PG8_SCHED; PG8_LDA(At, 1, 0); PG8_STAGE(PG8_SA(0, 1), a2 + hstep, voffA);
            PG8_WAIT_L(8); PG8_BAR; PG8_WAIT_L(0); PG8_MMA(0, 0, At, B0); PG8_BAR; PG8_SCHED;
            PG8_LDB(B1, 1, 1); PG8_STAGE(PG8_SB(1, 0), b3, voffB);
            PG8_BAR; PG8_WAIT_L(0); PG8_MMA(0, 1, At, B1); PG8_BAR;
            PG8_LDA(At, 1, 1); PG8_STAGE(PG8_SA(1, 0), a3, voffA);
            PG8_BAR; PG8_WAIT_L(0); PG8_MMA(1, 0, At, B0); PG8_BAR; PG8_SCHED;
            PG8_STAGE(PG8_SB(1, 1), b3 + hstep, voffB);
            PG8_WAIT_V(6); PG8_BAR; PG8_MMA(1, 1, At, B1); PG8_BAR;
            }
        }
        if constexpr (ALIGN_EPI) { if (wr == 0) PG8_BAR; }
        if constexpr (!Epi::AFTER_DRAIN) { E(acc, cur, wr, wc, fr, fq); S.done(cur); }
        if (!has_next) break;
#pragma unroll
        for (int a = 0; a < 2; ++a)
#pragma unroll
            for (int b = 0; b < 2; ++b)
#pragma unroll
                for (int m = 0; m < 4; ++m)
#pragma unroll
                    for (int n = 0; n < 2; ++n) acc[a][b][m][n] = (f32x4){0.f, 0.f, 0.f, 0.f};
        cur = nxt; cA = nA; cB = nB; ++ui;
        if constexpr (ALIGN_EPI) { if (wr == 1) PG8_BAR; }
    }
    PG8_WAIT_V(0);
    if constexpr (!ALIGN_EPI) { if (wr == 0) PG8_BAR; }
    PG8_BAR;
    if constexpr (Epi::AFTER_DRAIN) { E.fused(acc, cur, wr, wc, fr, fq, lds, wid, lane); S.done(cur); }
#undef PG8_SA
#undef PG8_SB
#undef PG8_STAGE
#undef PG8_LDA
#undef PG8_LDB
#undef PG8_MMA
#undef PG8_WAIT_V
#undef PG8_WAIT_L
#undef PG8_BAR
#undef PG8_SCHED
}
}

#ifndef PG8_SP2
#define PG8_SP2 true
#endif
#ifndef PG8_ALIGN
#define PG8_ALIGN true
#endif

#include <hip/hip_bf16.h>
#include <cmath>
namespace attn_body {
using bf16=__hip_bfloat16;
using bf16x8=__attribute__((ext_vector_type(8)))short;
using s16x4=__attribute__((ext_vector_type(4)))short;
using f32x16=__attribute__((ext_vector_type(16)))float;
using u32x4=__attribute__((ext_vector_type(4)))unsigned;
using f32x4_t=__attribute__((ext_vector_type(4)))float;
constexpr int BATCH=4,NHEAD=8,SEQ=8192,D=64,DM=NHEAD*D;
constexpr int NW=8,QBLK=32,QB=QBLK*NW,KVBLK=64,NQB=SEQ/QB;
constexpr int ATTN_PITCH=DM, ATTN_UNIT_ROWS=QB;
__device__ __forceinline__ int crow(int r,int hi){return (r&3)+8*(r>>2)+4*hi;}
#define SBAR() __builtin_amdgcn_sched_barrier(0)
__device__ __forceinline__ void cmask(f32x16&p0,f32x16&p1,int jb,int qrel,int hi){
  const float NEG=-INFINITY; int kb=64*jb+4*hi;
  #pragma unroll
  for(int r=0;r<16;++r){int kv=kb+(r&3)+8*(r>>2); if(kv>qrel)p0[r]=NEG; if(kv+32>qrel)p1[r]=NEG;}
}

constexpr int NSLOT=3, SLOTB=8192;
constexpr int LDS_K=0, LDS_V=NSLOT*SLOTB, LDS_WS=2*NSLOT*SLOTB, LDS_OST=LDS_WS+NW*64*4, LDS_F=LDS_OST+NW*4096, LDS_BYTES=LDS_F+SEQ*4;
constexpr float C2=0.125f*1.4426950408889634f;
__device__ __forceinline__ void glds16(const void*gsrc,unsigned lds_dst){unsigned keep;
  asm volatile("s_mov_b32 %0, m0\n\ts_mov_b32 m0, %2\n\ts_nop 0\n\tglobal_load_lds_dwordx4 %1, off\n\ts_mov_b32 m0, %0":"=&s"(keep):"v"(gsrc),"s"(lds_dst):"memory");}
__device__ __forceinline__ float max3f(float a,float b,float c){float r;asm("v_max3_f32 %0, %1, %2, %3":"=v"(r):"v"(a),"v"(b),"v"(c));return r;}
__device__ __forceinline__ float max2f(float a,float b){float r;asm("v_max_f32_e32 %0, %1, %2":"=v"(r):"v"(a),"v"(b));return r;}
__device__ __forceinline__ float fadd_s(float a,float b){float r;asm("v_add_f32_e32 %0, %1, %2":"=v"(r):"v"(a),"v"(b));return r;}
__device__ __forceinline__ float fsub_s(float a,float b){float r;asm("v_sub_f32_e32 %0, %1, %2":"=v"(r):"v"(a),"v"(b));return r;}
typedef float f32x2_t __attribute__((ext_vector_type(2))); typedef __bf16 bf16x2_t __attribute__((ext_vector_type(2)));
__device__ __forceinline__ unsigned cvtpk_s(float lo,float hi){f32x2_t v={lo,hi};bf16x2_t b=__builtin_convertvector(v,bf16x2_t);return __builtin_bit_cast(unsigned,b);}
#define WAIT_BAR(N) asm volatile("s_waitcnt vmcnt(" #N ") lgkmcnt(0)\n\ts_barrier":::"memory")

__device__ __forceinline__ void qkt(f32x16&p0,f32x16&p1,const char*Kslot,const bf16x8*qr,const f32x16&negm,int r32,int hi){
  const char*kb=Kslot+hi*1024+r32*16;
  #pragma unroll
  for(int d0=0;d0<4;++d0){
    const bf16x8 b0=*reinterpret_cast<const bf16x8*>(kb+d0*2048);
    const bf16x8 b1=*reinterpret_cast<const bf16x8*>(kb+d0*2048+512);
    {p0=__builtin_amdgcn_mfma_f32_32x32x16_bf16(b0,qr[d0],p0,0,0,0);p1=__builtin_amdgcn_mfma_f32_32x32x16_bf16(b1,qr[d0],p1,0,0,0);}}
}
typedef __attribute__((address_space(3))) const char* lds_cptr;
typedef short v4i16_t __attribute__((ext_vector_type(4)));
__device__ __forceinline__ void kload8(bf16x8*kf,lds_cptr kp){
  kf[0]=*(const __attribute__((address_space(3))) bf16x8*)(kp);      kf[1]=*(const __attribute__((address_space(3))) bf16x8*)(kp+512);
  kf[2]=*(const __attribute__((address_space(3))) bf16x8*)(kp+2048); kf[3]=*(const __attribute__((address_space(3))) bf16x8*)(kp+2560);
  kf[4]=*(const __attribute__((address_space(3))) bf16x8*)(kp+4096); kf[5]=*(const __attribute__((address_space(3))) bf16x8*)(kp+4608);
  kf[6]=*(const __attribute__((address_space(3))) bf16x8*)(kp+6144); kf[7]=*(const __attribute__((address_space(3))) bf16x8*)(kp+6656);
}
__device__ __forceinline__ void kload2(bf16x8*kf,lds_cptr kp,int j){ kf[2*j]=*(const __attribute__((address_space(3))) bf16x8*)(kp+j*2048); kf[2*j+1]=*(const __attribute__((address_space(3))) bf16x8*)(kp+j*2048+512); }
__device__ __forceinline__ s16x4 vtr(lds_cptr p){ return __builtin_bit_cast(s16x4,__builtin_amdgcn_ds_read_tr16_b64_v4i16((__attribute__((address_space(3))) v4i16_t*)p)); }
__device__ __forceinline__ float rowmax(const f32x16&p0,const f32x16&p1){
  float a=max3f(p0[0],p0[1],p1[0]),b=max3f(p0[2],p0[3],p1[1]);a=max3f(a,p1[2],p1[3]);
  #pragma unroll
  for(int r=4;r<16;r+=4){a=max3f(a,p0[r],p0[r+1]);b=max3f(b,p0[r+2],p0[r+3]);a=max3f(a,p1[r],p1[r+1]);b=max3f(b,p1[r+2],p1[r+3]);}
  const float m=max2f(a,b);
  auto rr=__builtin_amdgcn_permlane32_swap(__float_as_uint(m),__float_as_uint(m),false,false);
  return max2f(__uint_as_float(rr[0]),__uint_as_float(rr[1]));
}
__device__ __forceinline__ void pv(f32x16*o,int vb,bf16x8 pa0,bf16x8 pa1,bf16x8 pa2,bf16x8 pa3){
  #pragma unroll
  for(int d0=0;d0<2;++d0){s16x4 lo[4],hi[4];
    #pragma unroll
    for(int ks=0;ks<4;++ks){
      asm volatile("ds_read_b64_tr_b16 %0,%1 offset:%c2":"=&v"(lo[ks]):"v"(vb),"i"(d0*4096+ks*1024):"memory");
      asm volatile("ds_read_b64_tr_b16 %0,%1 offset:%c2":"=&v"(hi[ks]):"v"(vb),"i"(d0*4096+ks*1024+512):"memory");}
    asm volatile("s_waitcnt lgkmcnt(0)":::"memory");SBAR();
    #define PK(k) (bf16x8){lo[k][0],lo[k][1],lo[k][2],lo[k][3],hi[k][0],hi[k][1],hi[k][2],hi[k][3]}
    o[d0]=__builtin_amdgcn_mfma_f32_32x32x16_bf16(pa0,PK(0),o[d0],0,0,0);
    o[d0]=__builtin_amdgcn_mfma_f32_32x32x16_bf16(pa1,PK(1),o[d0],0,0,0);
    o[d0]=__builtin_amdgcn_mfma_f32_32x32x16_bf16(pa2,PK(2),o[d0],0,0,0);
    o[d0]=__builtin_amdgcn_mfma_f32_32x32x16_bf16(pa3,PK(3),o[d0],0,0,0);
    #undef PK
  }
}

#ifndef ATTN_STORE16
#define ATTN_STORE16(p,v) (*(u32x4*)(p)=(v))
#endif
template<int THRL> __device__ __forceinline__ void attn_unit(int b,int h,int qb,const bf16*Q,const bf16*__restrict__ K,const bf16*__restrict__ V,bf16*O,const float*__restrict__ Fc,char*shm){
  int tid_=threadIdx.x; asm volatile("":"+v"(tid_)); const int tid=tid_,lane=tid&63,r32=lane&31,hi=lane>>5; const int wid=__builtin_amdgcn_readfirstlane(tid>>6);
  const long rowbase=(long)b*SEQ; const int q0=qb*QB;
  const bf16*Qw=Q+(rowbase+q0+wid*QBLK)*DM+h*D;
  const bf16*Kh=K+rowbase*DM+h*D,*Vh=V+rowbase*DM+h*D;
  const unsigned lds0=(unsigned)(uintptr_t)shm;
  float*wsf=(float*)(shm+LDS_WS)+wid*64;
  const bf16*ksrc=Kh+(long)lane*DM+wid*8;
  const bf16*vsrc=Vh+(long)(16*(wid&3)+(lane>>2))*DM+(wid>>2)*32+(lane&3)*8;
  const unsigned kdst=lds0+LDS_K+wid*1024, vdst=lds0+LDS_V+wid*1024;
  #define DMA_K(t,slot) glds16(ksrc+(long)(t)*KVBLK*DM,(unsigned)__builtin_amdgcn_readfirstlane(kdst+(slot)))
  #define DMA_V(t,slot) glds16(vsrc+(long)(t)*KVBLK*DM,(unsigned)__builtin_amdgcn_readfirstlane(vdst+(slot)))
  const int vb0=(int)(lds0+LDS_V)+((lane>>4)&1)*32+(lane&3)*8+(4*hi+((lane&15)>>2))*64;
  const char*Kbase=shm+LDS_K; bf16x8 kf[8];
  const lds_cptr shm3=(lds_cptr)shm; const lds_cptr kp0=shm3+LDS_K+hi*1024+r32*16; const lds_cptr vp0=shm3+LDS_V+((lane>>4)&1)*32+(lane&3)*8+(4*hi+((lane&15)>>2))*64;
  const int NT=(q0+QB)/KVBLK;
  { const int nf4=(q0+QB)>>2; __attribute__((address_space(3))) f32x4_t* ft=(__attribute__((address_space(3))) f32x4_t*)((lds_cptr)shm+LDS_F); const f32x4_t* fs=(const f32x4_t*)Fc; for(int i=tid;i<nf4;i+=NW*64)ft[i]=fs[i]; }
  const float fq2=Fc[q0+wid*QBLK+r32];
  DMA_K(0,0);DMA_V(0,0);DMA_K(1,SLOTB);
  bf16x8 qr[4];
  #pragma unroll
  for(int d0=0;d0<4;++d0)qr[d0]=*reinterpret_cast<const bf16x8*>(&Qw[(long)r32*DM+d0*16+hi*8]);
  float mhat=-fq2,l_reg=0.f;f32x16 o[2];o[0]=f32x16{};o[1]=f32x16{};const f32x16 negm=f32x16{};
  const __attribute__((address_space(3))) float* fkb=(const __attribute__((address_space(3))) float*)((lds_cptr)shm+LDS_F)+4*hi;
  #define FBINIT(P0,P1,t) do{ const __attribute__((address_space(3))) float* fp_=fkb+(t)*64; const float nm_=-mhat; _Pragma("unroll") for(int j_=0;j_<4;++j_){ const f32x4_t a_=*(const __attribute__((address_space(3))) f32x4_t*)(fp_+8*j_), b_=*(const __attribute__((address_space(3))) f32x4_t*)(fp_+32+8*j_); \
      P0[4*j_]=nm_-a_[0];P0[4*j_+1]=nm_-a_[1];P0[4*j_+2]=nm_-a_[2];P0[4*j_+3]=nm_-a_[3]; P1[4*j_]=nm_-b_[0];P1[4*j_+1]=nm_-b_[1];P1[4*j_+2]=nm_-b_[2];P1[4*j_+3]=nm_-b_[3]; } }while(0)
  const int qrel=wid*QBLK+r32;
  #define CMASK(P0,P1,t) do{int jb_=(t)-(NT-4); if(jb_>=0)cmask(P0,P1,jb_,qrel,hi);}while(0)
  bool resc=false;
  #define START(P0,P1) do{ const float rm=rowmax(P0,P1); resc=false; \
    { const float dl=rm; mhat=fadd_s(mhat,dl); \
      _Pragma("unroll") for(int r=0;r<16;++r){P0[r]=fsub_s(P0[r],dl);P1[r]=fsub_s(P1[r],dl);} \
      } \
    _Pragma("unroll") for(int r=0;r<16;++r)P0[r]=__builtin_amdgcn_exp2f(P0[r]); }while(0)
  #define RESC() do{ if(resc){ asm volatile("s_waitcnt lgkmcnt(0)":::"memory"); \
      _Pragma("unroll") for(int d_=0;d_<2;++d_) _Pragma("unroll") for(int r=0;r<16;++r)o[d_][r]*=wsf[crow(r,hi)]; } }while(0)
  f32x16 pA0,pA1,pB0,pB1;
  int sl_prev=0,sl_cur=0,sl_next=SLOTB;
  #define ROT() do{sl_prev=sl_cur;sl_cur=sl_next;sl_next=(sl_next==(NSLOT-1)*SLOTB)?0:sl_next+SLOTB;}while(0)
  DMA_K(2,2*SLOTB);
  WAIT_BAR(3);
  FBINIT(pA0,pA1,0);
  qkt(pA0,pA1,Kbase,qr,negm,r32,hi);asm volatile("s_nop 15\n\ts_nop 7":"+v"(pA0),"+v"(pA1));CMASK(pA0,pA1,0);
  START(pA0,pA1);
  _Pragma("unroll") for(int r=0;r<16;++r)pA1[r]=__builtin_amdgcn_exp2f(pA1[r]);
  WAIT_BAR(0);
  DMA_K(3,0);DMA_V(1,SLOTB);
  ROT();
  kload8(kf,kp0+sl_cur);
  WAIT_BAR(2);
  s16x4 vlo[8],vhi[8]; u32x4 pw0,pw1,pw2,pw3;
  #define PKW(P,B) cvtpk_s(P[B],P[B+1])
  #define PAF(k) __builtin_bit_cast(bf16x8,pw##k)
  #define VFR(i) (bf16x8){vlo[i][0],vlo[i][1],vlo[i][2],vlo[i][3],vhi[i][0],vhi[i][1],vhi[i][2],vhi[i][3]}
  #define PIN(x) asm volatile("":"+v"(x))
  #define MX3(a,b,c) __builtin_fmaxf(__builtin_fmaxf((a),(b)),(c))
  #define GAPA(MF,A0,A1,A2,A3,W0,W1,PW) do{ MF; sacc+=A0; sacc+=A1; sacc+=A2; sacc+=A3; PIN(sacc); W0; W1; PIN(PW); SBAR(); }while(0)
  #define EX(v) __builtin_amdgcn_exp2f(v)
  #define GAPB(MF,X,B) do{ MF; X[B]=EX(X[B]); X[B+1]=EX(X[B+1]); X[B+2]=EX(X[B+2]); X[B+3]=EX(X[B+3]); PIN(X); SBAR(); }while(0)
  #define VRD(i) do{ vlo[i]=vtr(vp_+(((i)>>2)*4096+((i)&3)*1024)); vhi[i]=vtr(vp_+(((i)>>2)*4096+((i)&3)*1024+512)); }while(0)
  #define KRD(G,j) do{ if(G){ kload2(kf,kp0+sl_next,j); SBAR(); } }while(0)
  #define STEP(C0,C1,P0,P1,t,GK,GV,GL) do{ SBAR(); FBINIT(C0,C1,t); SBAR(); \
    const lds_cptr vp_=vp0+sl_prev; \
    VRD(0); SBAR(); float sacc=(P0[0]+P0[1]); \
    GAPA(C0=__builtin_amdgcn_mfma_f32_32x32x16_bf16(kf[0],qr[0],C0,0,0,0), P0[2],P0[3],P0[4],P0[5],     pw0[0]=PKW(P0,0), pw0[1]=PKW(P0,2), pw0); \
    VRD(4); SBAR(); GAPA(C1=__builtin_amdgcn_mfma_f32_32x32x16_bf16(kf[1],qr[0],C1,0,0,0), P0[6],P0[7],P0[8],P0[9],     pw0[2]=PKW(P0,4), pw0[3]=PKW(P0,6), pw0); \
    VRD(1); SBAR(); GAPA(C0=__builtin_amdgcn_mfma_f32_32x32x16_bf16(kf[2],qr[1],C0,0,0,0),   P0[10],P0[11],P0[12],P0[13], pw1[0]=PKW(P0,8), pw1[1]=PKW(P0,10), pw1); \
    VRD(5); SBAR(); GAPA(C1=__builtin_amdgcn_mfma_f32_32x32x16_bf16(kf[3],qr[1],C1,0,0,0),   P0[14],P0[15],P1[0],P1[1],   pw1[2]=PKW(P0,12),pw1[3]=PKW(P0,14), pw1); \
    VRD(2); SBAR(); GAPA(C0=__builtin_amdgcn_mfma_f32_32x32x16_bf16(kf[4],qr[2],C0,0,0,0),   P1[2],P1[3],P1[4],P1[5],     pw2[0]=PKW(P1,0), pw2[1]=PKW(P1,2), pw2); \
    VRD(6); SBAR(); GAPA(C1=__builtin_amdgcn_mfma_f32_32x32x16_bf16(kf[5],qr[2],C1,0,0,0),   P1[6],P1[7],P1[8],P1[9],     pw2[2]=PKW(P1,4), pw2[3]=PKW(P1,6), pw2); \
    VRD(3); SBAR(); GAPA(C0=__builtin_amdgcn_mfma_f32_32x32x16_bf16(kf[6],qr[3],C0,0,0,0),   P1[10],P1[11],P1[12],P1[13], pw3[0]=PKW(P1,8), pw3[1]=PKW(P1,10), pw3); \
    VRD(7); SBAR(); GAPA(C1=__builtin_amdgcn_mfma_f32_32x32x16_bf16(kf[7],qr[3],C1,0,0,0),   P1[14],P1[15],0.f,0.f,       pw3[2]=PKW(P1,12),pw3[3]=PKW(P1,14), pw3); \
    l_reg+=sacc; \
    if(GK){DMA_K((t)+3,sl_cur);} if(GV){DMA_V((t)+1,sl_next);} \
    CMASK(C0,C1,t); \
    { float a=MX3(C0[0],C0[1],C1[0]),b=MX3(C0[2],C0[3],C1[1]); a=MX3(a,C1[2],C1[3]); \
      _Pragma("unroll") for(int r=4;r<16;r+=4){a=MX3(a,C0[r],C0[r+1]);b=MX3(b,C0[r+2],C0[r+3]);a=MX3(a,C1[r],C1[r+1]);b=MX3(b,C1[r+2],C1[r+3]);} \
      float rm=__builtin_fmaxf(a,b); { auto rr=__builtin_amdgcn_permlane32_swap(__float_as_uint(rm),__float_as_uint(rm),false,false); rm=__builtin_fmaxf(__uint_as_float(rr[0]),__uint_as_float(rr[1])); } \
      resc=false; \
      if(__builtin_expect(__any(rm>(float)THRL),0)){ const float dl=__builtin_fmaxf(rm,0.f); mhat+=dl; \
        _Pragma("unroll") for(int r=0;r<16;++r){C0[r]-=dl;C1[r]-=dl;} \
        const float f=__builtin_amdgcn_exp2f(-dl); l_reg*=f; if(hi==0)wsf[r32]=f; resc=true; } } \
    SBAR(); \
    GAPB(o[0]=__builtin_amdgcn_mfma_f32_32x32x16_bf16(PAF(0),VFR(0),o[0],0,0,0), C0,0); \
    GAPB(o[1]=__builtin_amdgcn_mfma_f32_32x32x16_bf16(PAF(0),VFR(4),o[1],0,0,0), C0,4); \
    KRD(GL,0); GAPB(o[0]=__builtin_amdgcn_mfma_f32_32x32x16_bf16(PAF(1),VFR(1),o[0],0,0,0), C0,8); \
    KRD(GL,1); GAPB(o[1]=__builtin_amdgcn_mfma_f32_32x32x16_bf16(PAF(1),VFR(5),o[1],0,0,0), C0,12); \
    KRD(GL,2); GAPB(o[0]=__builtin_amdgcn_mfma_f32_32x32x16_bf16(PAF(2),VFR(2),o[0],0,0,0), C1,0); \
    KRD(GL,3); GAPB(o[1]=__builtin_amdgcn_mfma_f32_32x32x16_bf16(PAF(2),VFR(6),o[1],0,0,0), C1,4); \
    GAPB(o[0]=__builtin_amdgcn_mfma_f32_32x32x16_bf16(PAF(3),VFR(3),o[0],0,0,0), C1,8); \
    GAPB(o[1]=__builtin_amdgcn_mfma_f32_32x32x16_bf16(PAF(3),VFR(7),o[1],0,0,0), C1,12); \
    }while(0)
  int t=1;
  #undef CMASK
  #define CMASK(P0,P1,t) do{}while(0)
  for(;t+5<NT;t+=2){
    STEP(pB0,pB1,pA0,pA1,t,true,true,true);     WAIT_BAR(2); RESC(); ROT();
    STEP(pA0,pA1,pB0,pB1,t+1,true,true,true);   WAIT_BAR(2); RESC(); ROT();
  }
  #undef CMASK
  #define CMASK(P0,P1,t) do{int jb_=(t)-(NT-4); if(jb_>=0)cmask(P0,P1,jb_,qrel,hi);}while(0)
  #define ENDW(tt) do{ if((tt)+3<NT){WAIT_BAR(2);} else if((tt)+2<NT){WAIT_BAR(1);} else {WAIT_BAR(0);} }while(0)
  for(;t+1<NT;t+=2){
    STEP(pB0,pB1,pA0,pA1,t,(t+3<NT),(t+1<NT),(t+1<NT));       ENDW(t);   RESC(); ROT();
    STEP(pA0,pA1,pB0,pB1,t+1,(t+4<NT),(t+2<NT),(t+2<NT));     ENDW(t+1); RESC(); ROT();
  }
  STEP(pB0,pB1,pA0,pA1,NT-1,false,false,false); RESC();
  { float sacc=pB0[0]+pB0[1]; _Pragma("unroll") for(int r=2;r<16;++r)sacc+=pB0[r]; _Pragma("unroll") for(int r=0;r<16;++r)sacc+=pB1[r]; l_reg+=sacc;
    pw0=(u32x4){PKW(pB0,0),PKW(pB0,2),PKW(pB0,4),PKW(pB0,6)};pw1=(u32x4){PKW(pB0,8),PKW(pB0,10),PKW(pB0,12),PKW(pB0,14)};pw2=(u32x4){PKW(pB1,0),PKW(pB1,2),PKW(pB1,4),PKW(pB1,6)};pw3=(u32x4){PKW(pB1,8),PKW(pB1,10),PKW(pB1,12),PKW(pB1,14)};
    SBAR(); pv(o,vb0+sl_cur,PAF(0),PAF(1),PAF(2),PAF(3)); }
  #undef PKW
  #undef PAF
  #undef VFR
  #undef PIN
  #undef MX3
  #undef GAPA
  #undef GAPB
  #undef EX
  #undef VRD
  #undef KRD
  #undef STEP
  #undef ENDW
  {auto rr=__builtin_amdgcn_permlane32_swap(__float_as_uint(l_reg),__float_as_uint(l_reg),false,false);l_reg=__uint_as_float(rr[0])+__uint_as_float(rr[1]);}
  if(hi==0)wsf[32+r32]=l_reg;asm volatile("s_waitcnt lgkmcnt(0)":::"memory");
  float rli[16];
  #pragma unroll
  for(int r=0;r<16;++r)rli[r]=__builtin_amdgcn_rcpf(wsf[32+crow(r,hi)]);
  bf16*Ow=O+(rowbase+q0+wid*QBLK)*DM+h*D;
  { bf16*stg=(bf16*)(shm+LDS_OST)+wid*2048;
    #pragma unroll
    for(int r=0;r<16;++r){const int orow=crow(r,hi);
      #pragma unroll
      for(int d0=0;d0<2;++d0)stg[orow*64+d0*32+r32]=__float2bfloat16(o[d0][r]*rli[r]);}
    asm volatile("s_waitcnt lgkmcnt(0)":::"memory");
    #pragma unroll
    for(int i=0;i<4;++i){const int row=i*8+(lane>>3),ch=lane&7; const u32x4 v=*(const u32x4*)(stg+row*64+ch*8); ATTN_STORE16(Ow+(long)row*DM+ch*8,v);} }
  asm volatile("s_waitcnt lgkmcnt(0)\n\ts_barrier":::"memory");
  #undef FBINIT
  #undef DMA_K
  #undef DMA_V
  #undef CMASK
  #undef START
  #undef RESC
  #undef ROT
}
constexpr int ATTN_LDS_BYTES=LDS_BYTES;
struct AttnTensors { const bf16* Q; const bf16* K; const bf16* V; bf16* O; const float* F; };
struct AttnUnit { int bh; int qb; };
struct StaticOrder {
  int vcu;
  __device__ __forceinline__ explicit StaticOrder(int grid,int block):vcu((block%8)*(grid/8)+block/8){}
  __device__ __forceinline__ bool next(int i,AttnUnit&u)const{ if(i>=4)return false; const int s=vcu&7; u.bh=vcu>>3; u.qb=(i==0)?s:(i==1)?15-s:(i==2)?16+s:31-s; return true; }
  __device__ __forceinline__ void a_ready(const AttnUnit&)const{}
  __device__ __forceinline__ void done(const AttnUnit&)const{}
};
template<class Sched,int THRL=8> __device__ __forceinline__ void attn_phase(char*lds,const AttnTensors&T,const Sched&S){
  AttnUnit u;
  for(int i=0;S.next(i,u);++i){ S.a_ready(u); attn_unit<THRL>(u.bh/NHEAD,u.bh%NHEAD,u.qb,T.Q,T.K,T.V,T.O,T.F+(size_t)u.bh*SEQ,lds); S.done(u); }
}
#undef SBAR
#undef WAIT_BAR
}

#define LAS __attribute__((address_space(3)))
typedef unsigned short bf16;
typedef float f32x4 __attribute__((ext_vector_type(4)));
typedef float f32x2 __attribute__((ext_vector_type(2)));
typedef unsigned v4u __attribute__((ext_vector_type(4)));
typedef unsigned v2u __attribute__((ext_vector_type(2)));

constexpr int T_ = 32768, SEQ = 8192, NWAVES = 8, DFF = 2816, NIN = 7192;
constexpr float LOG2E = 1.4426950408889634f;
constexpr int LDS_BYTES = 147456;
constexpr int NPHASE = 31;
constexpr size_t MiB = (size_t)1 << 20;
constexpr size_t WS_W = 1 * MiB;
constexpr size_t W_1U = 0, W_1D = W_1U + (size_t)5632 * 1024 * 2, W_IN = W_1D + (size_t)1024 * 2816 * 2, W_G = W_IN + (size_t)4352 * 1024 * 2,
                 W_BR = W_G + (size_t)3072 * 1024 * 2, W_O = W_BR + (size_t)3 * 1024 * 512 * 2, W_2U = W_O + (size_t)1024 * 1024 * 2, W_2D = W_2U + (size_t)5632 * 1024 * 2,
                 W_PG = W_2D + (size_t)1024 * 2816 * 2, W_PP = W_PG + (size_t)1024 * 1024 * 2, W_END = W_PP + (size_t)1024 * 256 * 2;
static_assert(W_END == 55 * MiB, "weight map");
constexpr size_t WS_XB = 56 * MiB;
constexpr size_t WS_FC = 120 * MiB;
constexpr size_t WS_LRUS = 121 * MiB;
constexpr size_t WS_LRUC = 122 * MiB;
constexpr size_t WS_EG = 123 * MiB;
constexpr size_t WS_BIG = 124 * MiB;
constexpr size_t B_H = 0;
constexpr size_t B_AX = 0, B_GQ = 32 * MiB, B_GK = 48 * MiB, B_AY = 64 * MiB, B_GV = 96 * MiB, B_GR = 128 * MiB, B_CQ = 160 * MiB, B_CK = 192 * MiB, B_CV = 224 * MiB;
constexpr size_t B_LOW = 256 * MiB, B_FL = 258 * MiB, B_GST = 260 * MiB, B_END = 324 * MiB;
constexpr size_t B_S = 0  , B_P = 192 * MiB  , B_PB = 0  , B_S2 = 64 * MiB;
constexpr size_t WS_END = WS_BIG + B_END;

__device__ __forceinline__ float wave_sum(float v) {
#pragma unroll
    for (int o = 1; o < 64; o <<= 1) v += __shfl_xor(v, o);
    return v;
}
__device__ __forceinline__ float sigm(float x) { return __builtin_amdgcn_rcpf(1.0f + __builtin_amdgcn_exp2f(-LOG2E * x)); }
__device__ __forceinline__ float log_sigmoid(float x) { return fminf(x, 0.f) - log1pf(__expf(-fabsf(x))); }
__device__ __forceinline__ float gelu_tanh(float x) { const float u = 0.7978845608028654f * (x + 0.044715f * x * x * x); return x * sigm(2.0f * u); }
__device__ __forceinline__ float bflo(unsigned w) { return __uint_as_float(w << 16); }
__device__ __forceinline__ float bfhi(unsigned w) { return __uint_as_float(w & 0xffff0000u); }
__device__ __forceinline__ float bf2f(bf16 h) { return __uint_as_float(((unsigned)h) << 16); }
__device__ __forceinline__ unsigned pk2(float lo, float hi) { return pg8::cvt_pk_bf16(lo, hi); }
__device__ __forceinline__ bf16 f2bf(float f) { return (bf16)(pk2(f, 0.f) & 0xffffu); }

__device__ __forceinline__ int tr_row(int kind, int r0, int j) { if (kind == 0) return r0 + j; const int up = j >= DFF ? 1 : 0, c = j - up * DFF; return 256 * (c >> 7) + 128 * up + (c & 127); }
__device__ __forceinline__ void tr_item(const float* W, int K, int ldn, int c0, int nc, bf16* WT, int r0, int kind, LAS float* scr, int item, int lane) {
    const int nblk = (nc + 31) >> 5, kb = item / nblk, nb = item - kb * nblk, k0 = 64 * kb, n0 = 32 * nb;
    const int cl = n0 + (lane & 31); const bool okc = cl < nc;
#pragma unroll 8
    for (int i = 0; i < 32; ++i) { const int kk = 2 * i + (lane >> 5); scr[kk * 33 + (lane & 31)] = okc ? W[(size_t)(k0 + kk) * ldn + c0 + cl] : 0.f; }
    asm volatile("s_waitcnt lgkmcnt(0)" ::: "memory");
    const int c = lane & 7;
#pragma unroll
    for (int j = 0; j < 4; ++j) { const int n = (lane >> 3) + 8 * j; const LAS float* s = scr + (8 * c) * 33 + n;
        v4u o; o.x = pk2(s[0 * 33], s[1 * 33]); o.y = pk2(s[2 * 33], s[3 * 33]); o.z = pk2(s[4 * 33], s[5 * 33]); o.w = pk2(s[6 * 33], s[7 * 33]);
        if (n0 + n < nc) *(v4u*)(WT + (size_t)tr_row(kind, r0, n0 + n) * K + k0 + 8 * c) = o; }
    asm volatile("s_waitcnt lgkmcnt(0)" ::: "memory");
}
__device__ __forceinline__ void tr_seg(const float* W, int K, int ldn, int c0, int nc, bf16* WT, int r0, int kind, LAS float* scr, int gw, int NGW, int lane, int& rot) {
    const int nblk = (nc + 31) >> 5, nit = (K >> 6) * nblk;
    int start = gw - rot; if (start < 0) start += NGW;
    for (int it = start; it < nit; it += NGW) tr_item(W, K, ldn, c0, nc, WT, r0, kind, scr, it, lane);
    rot = (rot + nit) % NGW;
}
struct Args { const float* in[31]; float* out; unsigned char* ws; int ph_lo, ph_hi; };
__device__ __forceinline__ void convert_weights(const Args& a, int z, int l, unsigned char* wsw, LAS float* scr, int gw, int NGW, int lane) {
    int rot = 0;
    tr_seg(a.in[2 + z] + (size_t)l * 1024 * 5632, 1024, 5632, 0, 5632, (bf16*)(wsw + W_1U), 0, 1, scr, gw, NGW, lane, rot);
    tr_seg(a.in[3 + z] + (size_t)l * 2816 * 1024, 2816, 1024, 0, 1024, (bf16*)(wsw + W_1D), 0, 0, scr, gw, NGW, lane, rot);
    const float* win = a.in[6 + z] + (size_t)l * 1024 * NIN; bf16* WIN = (bf16*)(wsw + W_IN);
    tr_seg(win, 1024, NIN, 0, 2048, WIN, 0, 0, scr, gw, NGW, lane, rot);
    tr_seg(win, 1024, NIN, 2064, 2048, WIN, 2048, 0, scr, gw, NGW, lane, rot);
    tr_seg(win, 1024, NIN, 2048, 16, WIN, 4096, 0, scr, gw, NGW, lane, rot);
    tr_seg(win, 1024, NIN, 4112, 8, WIN, 4112, 0, scr, gw, NGW, lane, rot);
    tr_seg(win, 1024, NIN, 4120, 3072, (bf16*)(wsw + W_G), 0, 0, scr, gw, NGW, lane, rot);
    for (int j = 0; j < 3; ++j) tr_seg(a.in[18 + z] + ((size_t)l * 3 + j) * 512 * 1024, 512, 1024, 0, 1024, (bf16*)(wsw + W_BR) + (size_t)j * 1024 * 512, 0, 0, scr, gw, NGW, lane, rot);
    tr_seg(a.in[19 + z] + (size_t)l * 1024 * 1024, 1024, 1024, 0, 1024, (bf16*)(wsw + W_O), 0, 0, scr, gw, NGW, lane, rot);
    tr_seg(a.in[22 + z] + (size_t)l * 1024 * 5632, 1024, 5632, 0, 5632, (bf16*)(wsw + W_2U), 0, 1, scr, gw, NGW, lane, rot);
    tr_seg(a.in[23 + z] + (size_t)l * 2816 * 1024, 2816, 1024, 0, 1024, (bf16*)(wsw + W_2D), 0, 0, scr, gw, NGW, lane, rot);
    tr_seg(a.in[27 + z] + (size_t)l * 1024 * 1024, 1024, 1024, 0, 1024, (bf16*)(wsw + W_PG), 0, 0, scr, gw, NGW, lane, rot);
    tr_seg(a.in[26 + z] + (size_t)l * 256 * 1024, 256, 1024, 0, 1024, (bf16*)(wsw + W_PP), 0, 0, scr, gw, NGW, lane, rot);
}
__device__ __forceinline__ void ln_phase(float* X, bf16* XB, const float* g, const float* b, int gw, int NGW, int lane) {
    f32x4 gv[4], bv[4];
#pragma unroll
    for (int j = 0; j < 4; ++j) { gv[j] = *(const f32x4*)(g + 4 * lane + 256 * j); bv[j] = *(const f32x4*)(b + 4 * lane + 256 * j); }
    for (int m = gw; m < T_; m += NGW) {
        f32x4* xr = (f32x4*)(X + (size_t)m * 1024) + lane; f32x4 v[4]; float s = 0.f;
#pragma unroll
        for (int j = 0; j < 4; ++j) { v[j] = xr[64 * j]; s += (v[j].x + v[j].y) + (v[j].z + v[j].w); }
        const float mean = wave_sum(s) * (1.f / 1024.f); float s2 = 0.f;
#pragma unroll
        for (int j = 0; j < 4; ++j) { v[j] = v[j] - mean; s2 += (v[j].x * v[j].x + v[j].y * v[j].y) + (v[j].z * v[j].z + v[j].w * v[j].w); }
        const float rstd = 1.f / sqrtf(wave_sum(s2) * (1.f / 1024.f) + 1e-5f);
        v2u* o8 = (v2u*)(XB + (size_t)m * 1024) + lane;
#pragma unroll
        for (int j = 0; j < 4; ++j) { const f32x4 y = v[j] * rstd * gv[j] + bv[j]; xr[64 * j] = y; v2u w; w.x = pk2(y.x, y.y); w.y = pk2(y.z, y.w); o8[64 * j] = w; }
    }
}
__device__ __forceinline__ void cvt_rows(const float* src, bf16* dst, size_t n4, int gtid, int nthr) {
    for (size_t i = gtid; i < n4; i += nthr) { const f32x4 v = ((const f32x4*)src)[i]; v2u w; w.x = pk2(v.x, v.y); w.y = pk2(v.z, v.w); ((v2u*)dst)[i] = w; }
}
__device__ __forceinline__ void fcum_item(int bh, const float* FL, const float* bfl, float* FC, LAS float* sm, int tid, int lane, int wave) {
    const int b = bh >> 3, h = bh & 7; const float bfh = bfl[h];
    float v[16]; float run = 0.f;
#pragma unroll
    for (int j = 0; j < 16; ++j) { const int s = tid * 16 + j; run += log_sigmoid(FL[((size_t)(b * SEQ + s)) * 8 + h] + bfh); v[j] = run; }
    float inc = run;
#pragma unroll
    for (int o = 1; o < 64; o <<= 1) { const float t = __shfl_up(inc, o); if (lane >= o) inc += t; }
    if (lane == 63) sm[wave] = inc;
    __syncthreads();
    float woff = 0.f;
#pragma unroll
    for (int w = 0; w < 8; ++w) if (w < wave) woff += sm[w];
    const float off = woff + inc - run;
    f32x4* dst = (f32x4*)(FC + (size_t)bh * SEQ + tid * 16);
#pragma unroll
    for (int j = 0; j < 4; ++j) dst[j] = (f32x4){(off + v[4 * j]) * LOG2E, (off + v[4 * j + 1]) * LOG2E, (off + v[4 * j + 2]) * LOG2E, (off + v[4 * j + 3]) * LOG2E};
    __syncthreads();
}
template <int MODE> __device__ __forceinline__ void lru_item(int item, const bf16* AX, bf16* AY, const float* cw, const float* cb, const float* wa, const float* ba, const float* wx, const float* bx, const float* lam,
                                                            float* LRUS, const float* LRUC, LAS unsigned char* lds, int tid) {
    const int n = item & 7, c = (item >> 3) & 63, b = item >> 9;
    LAS float* XC = (LAS float*)lds;
    LAS float* PL = XC + 128 * 64;
    LAS float* SG = PL + 128 * 64;
    {   const int ch4 = tid & 15, tt = tid >> 4; const int chn = n * 64 + 4 * ch4;
        f32x4 cwv[4];
#pragma unroll
        for (int k = 0; k < 4; ++k) cwv[k] = *(const f32x4*)(cw + k * 512 + chn);
        const f32x4 cbv = *(const f32x4*)(cb + chn);
#pragma unroll
        for (int ps = 0; ps < 4; ++ps) { const int t = ps * 32 + tt; f32x4 acc = cbv;
#pragma unroll
            for (int k = 0; k < 4; ++k) { const int pos = c * 128 + t - 3 + k;
                if (pos >= 0) { const v2u w = *(const v2u*)(AX + ((size_t)(b * SEQ + pos)) * 512 + chn); acc += cwv[k] * (f32x4){bflo(w.x), bfhi(w.x), bflo(w.y), bfhi(w.y)}; } }
            *(LAS f32x4*)(XC + t * 64 + 4 * ch4) = acc; }
    }
    __syncthreads();
    const int d = tid & 63, seg = tid >> 6; const int chd = n * 64 + d;
    f32x2 w[32];
    const float lm = lam[chd]; const float sp = fmaxf(-lm, 0.f) + log1pf(__expf(-fabsf(lm)));
#pragma unroll
    for (int k = 0; k < 32; ++k) { w[k].x = wa[((size_t)(n * 64 + 2 * k)) * 64 + d]; w[k].y = wa[((size_t)(n * 64 + 2 * k + 1)) * 64 + d]; }
    {   const float bav = ba[chd];
#pragma unroll 1
        for (int j = 0; j < 16; ++j) { const int t = seg * 16 + j; const LAS f32x4* xr = (const LAS f32x4*)(XC + t * 64);
            f32x2 acc = (f32x2){bav, 0.f};
#pragma unroll
            for (int c4 = 0; c4 < 16; ++c4) { const f32x4 x = xr[c4]; acc += w[2 * c4] * (f32x2){x.x, x.y}; acc += w[2 * c4 + 1] * (f32x2){x.z, x.w}; }
            PL[t * 64 + d] = acc.x + acc.y; }
    }
    asm volatile("" ::: "memory");
#pragma unroll
    for (int k = 0; k < 32; ++k) { w[k].x = wx[((size_t)(n * 64 + 2 * k)) * 64 + d]; w[k].y = wx[((size_t)(n * 64 + 2 * k + 1)) * 64 + d]; }
    float hrun = 0.f, prun = 1.f;
    {   const float bxv = bx[chd];
#pragma unroll 1
        for (int j = 0; j < 16; ++j) { const int t = seg * 16 + j; const LAS f32x4* xr = (const LAS f32x4*)(XC + t * 64);
            f32x2 acc = (f32x2){bxv, 0.f};
#pragma unroll
            for (int c4 = 0; c4 < 16; ++c4) { const f32x4 x = xr[c4]; acc += w[2 * c4] * (f32x2){x.x, x.y}; acc += w[2 * c4 + 1] * (f32x2){x.z, x.w}; }
            const float xv = XC[t * 64 + d];
            const float r = sigm(PL[t * 64 + d]), ig = sigm(acc.x + acc.y); const float la = -8.0f * r * sp; const float av = __expf(la); const float mult = sqrtf(-expm1f(2.0f * la));
            hrun = av * hrun + mult * ig * xv; prun *= av;
            if (MODE == 1) { XC[t * 64 + d] = hrun; PL[t * 64 + d] = prun; } }
    }
    SG[(seg * 64 + d) * 2] = prun; SG[(seg * 64 + d) * 2 + 1] = hrun;
    __syncthreads();
    if (MODE == 0) {
        if (seg == 0) { float A = 1.f, H = 0.f;
#pragma unroll
            for (int s = 0; s < 8; ++s) { const float p = SG[(s * 64 + d) * 2], hh = SG[(s * 64 + d) * 2 + 1]; H = p * H + hh; A *= p; }
            *(f32x2*)(LRUS + ((size_t)((b * 64 + c) * 512 + chd)) * 2) = (f32x2){A, H}; }
    } else {
        float Hin = LRUC[(size_t)(b * 64 + c) * 512 + chd];
#pragma unroll
        for (int s = 0; s < 8; ++s) if (s < seg) Hin = SG[(s * 64 + d) * 2] * Hin + SG[(s * 64 + d) * 2 + 1];
#pragma unroll 4
        for (int j = 0; j < 16; ++j) { const int t = seg * 16 + j; const float hf = XC[t * 64 + d] + PL[t * 64 + d] * Hin;
            bf16* p = AY + ((size_t)(b * SEQ + c * 128 + t)) * 512 + chd; *p = f2bf(gelu_tanh(bf2f(*p)) * hf); }
    }
    __syncthreads();
}
__device__ __forceinline__ void gla_delta_item(int item, const bf16* GK, const bf16* GV, const float* LOW, const float* wg2, const float* bg, float* GST, float* EG, LAS unsigned char* lds, int tid) {
    const int h = item & 3, n = (item >> 2) & 127, b = item >> 9; const int row0 = b * SEQ + n * 64;
    LAS float* KD = (LAS float*)lds;
    LAS float* V = KD + 4096;
    LAS float* SEG = V + 8192;
    const int dk = tid & 63, tg = tid >> 6;
    float wv[16];
#pragma unroll
    for (int r = 0; r < 16; ++r) wv[r] = wg2[r * 256 + h * 64 + dk];
    const float bgv = bg[h * 64 + dk];
    float la[8]; float run = 0.f;
#pragma unroll
    for (int j = 0; j < 8; ++j) { const int t = tg * 8 + j; const f32x4* lr = (const f32x4*)(LOW + (size_t)(row0 + t) * 16); float z = bgv;
#pragma unroll
        for (int q = 0; q < 4; ++q) { const f32x4 x = lr[q]; z += x.x * wv[4 * q] + x.y * wv[4 * q + 1] + x.z * wv[4 * q + 2] + x.w * wv[4 * q + 3]; }
        run += log_sigmoid(z) * (1.0f / 16.0f); la[j] = run; }
    SEG[tg * 64 + dk] = run;
    {   const int t = tid >> 3, c16 = (tid & 7) * 16; const v4u* src = (const v4u*)(GV + (size_t)(row0 + t) * 512 + h * 128 + c16); const v4u a = src[0], c = src[1];
        LAS f32x4* dst = (LAS f32x4*)(V + t * 128 + c16);
        dst[0] = (f32x4){bflo(a.x), bfhi(a.x), bflo(a.y), bfhi(a.y)}; dst[1] = (f32x4){bflo(a.z), bfhi(a.z), bflo(a.w), bfhi(a.w)};
        dst[2] = (f32x4){bflo(c.x), bfhi(c.x), bflo(c.y), bfhi(c.y)}; dst[3] = (f32x4){bflo(c.z), bfhi(c.z), bflo(c.w), bfhi(c.w)}; }
    __syncthreads();
    float off = 0.f, tot = 0.f;
#pragma unroll
    for (int s = 0; s < 8; ++s) { const float x = SEG[s * 64 + dk]; tot += x; if (s < tg) off += x; }
#pragma unroll
    for (int j = 0; j < 8; ++j) { const int t = tg * 8 + j; const float kv = bf2f(GK[(size_t)(row0 + t) * 256 + h * 64 + dk]); KD[t * 64 + dk] = kv * __expf(tot - (off + la[j])); }
    if (tg == 0) EG[(size_t)item * 64 + dk] = __expf(tot);
    __syncthreads();
    const int dv4 = tid & 31, dkg = tid >> 5;
    f32x4 acc[4];
#pragma unroll
    for (int i = 0; i < 4; ++i) acc[i] = (f32x4){0.f, 0.f, 0.f, 0.f};
#pragma unroll 8
    for (int t = 0; t < 64; ++t) { const f32x4 kd = *(const LAS f32x4*)(KD + t * 64 + dkg * 4); const f32x4 vv = *(const LAS f32x4*)(V + t * 128 + dv4 * 4);
        acc[0] += vv * kd.x; acc[1] += vv * kd.y; acc[2] += vv * kd.z; acc[3] += vv * kd.w; }
#pragma unroll
    for (int i = 0; i < 4; ++i) *(f32x4*)(GST + ((size_t)item * 64 + dkg * 4 + i) * 128 + dv4 * 4) = acc[i];
    __syncthreads();
}
__device__ __forceinline__ void gla_scan(float* GST, const float* EG, int gtid, int nthr) {
    for (int g = gtid; g < 131072; g += nthr) {
        const int dv = g & 127, dk = (g >> 7) & 63, h = (g >> 13) & 3, b = g >> 15; float st = 0.f;
#pragma unroll 1
        for (int n0 = 0; n0 < 128; n0 += 8) { float dl[8], e[8];
#pragma unroll
            for (int i = 0; i < 8; ++i) { const size_t cbi = (size_t)((b * 128 + n0 + i) * 4 + h); dl[i] = GST[(cbi * 64 + dk) * 128 + dv]; e[i] = EG[cbi * 64 + dk]; }
#pragma unroll
            for (int i = 0; i < 8; ++i) { const size_t cbi = (size_t)((b * 128 + n0 + i) * 4 + h); st = e[i] * st + dl[i]; GST[(cbi * 64 + dk) * 128 + dv] = st; } }
    }
}
__device__ __forceinline__ void lru_carry(const float* LRUS, float* LRUC, int gtid) {
    if (gtid < 2048) { const int b = gtid >> 9, ch = gtid & 511; float H = 0.f;
#pragma unroll 8
        for (int c = 0; c < 64; ++c) { const size_t i = (size_t)(b * 64 + c) * 512 + ch; LRUC[i] = H; const f32x2 s = *(const f32x2*)(LRUS + i * 2); H = s.x * H + s.y; } }
}
__device__ __forceinline__ void gla_out_item(int item, const bf16* GQ, bf16* GR, const float* GST, const float* ng, LAS unsigned char* lds, int tid) {
    const int h = item & 3, np = (item >> 2) & 63, b = item >> 8;
    const int half = tid >> 8, lt = tid & 255; const int n = np * 2 + half; const int row0 = b * SEQ + n * 64;
    LAS float* QT = (LAS float*)lds + half * (4096 + 8192);
    LAS float* ST = QT + 4096;
    {   const int t = lt >> 2, d0 = (lt & 3) * 16; const v4u* src = (const v4u*)(GQ + (size_t)(row0 + t) * 256 + h * 64 + d0); const v4u a = src[0], c = src[1];
#pragma unroll
        for (int i = 0; i < 4; ++i) { QT[(d0 + 2 * i) * 64 + t] = bflo(a[i]); QT[(d0 + 2 * i + 1) * 64 + t] = bfhi(a[i]); QT[(d0 + 8 + 2 * i) * 64 + t] = bflo(c[i]); QT[(d0 + 8 + 2 * i + 1) * 64 + t] = bfhi(c[i]); }
        const f32x4* ss = (const f32x4*)(GST + ((size_t)((b * 128 + n) * 4 + h)) * 8192);
#pragma unroll
        for (int i = 0; i < 8; ++i) ((LAS f32x4*)ST)[lt + 256 * i] = ss[lt + 256 * i]; }
    __syncthreads();
    const int dv4 = lt & 31, tg = lt >> 5;
    f32x4 acc[8];
#pragma unroll
    for (int i = 0; i < 8; ++i) acc[i] = (f32x4){0.f, 0.f, 0.f, 0.f};
#pragma unroll 4
    for (int dk = 0; dk < 64; ++dk) { const f32x4 s = *(const LAS f32x4*)(ST + dk * 128 + dv4 * 4); const f32x4 qa = *(const LAS f32x4*)(QT + dk * 64 + tg * 8), qb = *(const LAS f32x4*)(QT + dk * 64 + tg * 8 + 4);
        acc[0] += s * qa.x; acc[1] += s * qa.y; acc[2] += s * qa.z; acc[3] += s * qa.w; acc[4] += s * qb.x; acc[5] += s * qb.y; acc[6] += s * qb.z; acc[7] += s * qb.w; }
    const f32x4 g = *(const f32x4*)(ng + h * 128 + dv4 * 4);
#pragma unroll
    for (int j = 0; j < 8; ++j) { const f32x4 o = acc[j]; float ss = (o.x * o.x + o.y * o.y) + (o.z * o.z + o.w * o.w);
        ss += __shfl_xor(ss, 1); ss += __shfl_xor(ss, 2); ss += __shfl_xor(ss, 4); ss += __shfl_xor(ss, 8); ss += __shfl_xor(ss, 16);
        const float rs = 1.0f / sqrtf(ss * (1.0f / 128.0f) + 1e-6f);
        v2u* p = (v2u*)(GR + (size_t)(row0 + tg * 8 + j) * 512 + h * 128 + dv4 * 4); const v2u rv = *p;
        const float r0 = bflo(rv.x), r1 = bfhi(rv.x), r2 = bflo(rv.y), r3 = bfhi(rv.y);
        v2u w; w.x = pk2(o.x * rs * g.x * (r0 * sigm(r0)), o.y * rs * g.y * (r1 * sigm(r1))); w.y = pk2(o.z * rs * g.z * (r2 * sigm(r2)), o.w * rs * g.w * (r3 * sigm(r3))); *p = w; }
    __syncthreads();
}

#ifndef MK_MULTI
#define MK_MULTI 1
#endif
#define PH_ON(k) (ONLY < 0 || ONLY == (k))
#ifndef MK_SUB
#define MK_SUB -1
#endif
#define SUB_ON(k) (MK_SUB < 0 || MK_SUB == (k))
template <int ONLY> __device__ __forceinline__ void phase_body(const Args& args, const int ph, unsigned char* lds) {
    {
        int z = 0; asm volatile("" : "+s"(z));
        int tid = threadIdx.x; asm volatile("" : "+v"(tid));
        const int lane = tid & 63, wave = __builtin_amdgcn_readfirstlane(tid >> 6);
        const int G = gridDim.x + z, bx = blockIdx.x + z;
        const int gw = bx * NWAVES + wave, NGW = G * NWAVES, gtid = bx * (NWAVES * 64) + tid, nthr = G * NWAVES * 64;
        LAS unsigned char* l3 = (LAS unsigned char*)lds + z;
        LAS float* scr = (LAS float*)(l3 + wave * 16384);
        unsigned char* ws = args.ws + z; unsigned char* wsw = ws + WS_W; unsigned char* big = ws + WS_BIG;
        float* X = args.out + z; bf16* XB = (bf16*)(ws + WS_XB);
        if (PH_ON(100) && ph == 0) {
            convert_weights(args, z, 0, wsw, scr, gw, NGW, lane);
            const f32x4* xs = (const f32x4*)args.in[(0) + z];
            for (size_t i = gtid; i < (size_t)T_ * 256; i += nthr) { const f32x4 v = xs[i]; ((f32x4*)X)[i] = v; v2u w; w.x = pk2(v.x, v.y); w.y = pk2(v.z, v.w); ((v2u*)XB)[i] = w; }
        } else {
            const int q = ph - 1, l = q / 15, s = q - l * 15;
            if (PH_ON(0) && (s == 0 || s == 10)) {
                pg8::Gemm g{XB, (const bf16*)(wsw + (s == 0 ? W_1U : W_2U)), T_, 5632, 1024}; pg8::StaticOrder S; S.init(T_, 5632, G, bx);
                pg8::EpiSwiglu E{(bf16*)(big + B_H), DFF};
                pg8::gemm_phase<pg8::EpiSwiglu, pg8::StaticOrder, PG8_ALIGN, PG8_SP2>(l3, g, S, E);
            } else if (PH_ON(1) && (s == 1 || s == 11 || s == 8)) {
#ifdef MK_DBG_A
                const bf16* A = (s == 8) ? (const bf16*)(big + MK_DBG_A) : (const bf16*)(big + B_H);
#else
                const bf16* A = (s == 8) ? (const bf16*)(big + B_P) : (const bf16*)(big + B_H);
#endif
                const bf16* Bt = (const bf16*)(wsw + (s == 1 ? W_1D : (s == 11 ? W_2D : W_O)));
                pg8::Gemm g{A, Bt, T_, 1024, (s == 8) ? 1024 : DFF}; pg8::StaticOrder S; S.init(T_, 1024, G, bx);
                pg8::EpiResid E{X, (s == 8) ? 1.0f : 0.5f};
                pg8::gemm_phase<pg8::EpiResid, pg8::StaticOrder, PG8_ALIGN, PG8_SP2>(l3, g, S, E);
            } else if (PH_ON(2) && (s == 2 || s == 9 || s == 12 || s == 14)) {
                const int gi = (s == 2) ? 4 : (s == 9 ? 20 : (s == 12 ? 24 : 29));
                ln_phase(X, XB, args.in[(gi) + z] + (size_t)l * 1024, args.in[(gi + 1) + z] + (size_t)l * 1024, gw, NGW, lane);
                if (s == 12) cvt_rows(args.in[(1) + z] + (size_t)l * T_ * 256, (bf16*)(big + B_PB), (size_t)T_ * 64, gtid, nthr);
                if (s == 14 && l == 0) convert_weights(args, z, 1, wsw, scr, gw, NGW, lane);
            } else if (PH_ON(3) && s == 3) {
                pg8::Gemm g{XB, (const bf16*)(wsw + W_IN), T_, 4352, 1024}; pg8::StaticOrder S; S.init(T_, 4352, G, bx);
                pg8::EpiMixIn E{(bf16*)big, (float*)(big + B_LOW), (float*)(big + B_FL), attn_body::C2};
                pg8::gemm_phase<pg8::EpiMixIn, pg8::StaticOrder, PG8_ALIGN, PG8_SP2>(l3, g, S, E);
            } else if (PH_ON(4) && s == 4) {
                if (bx < 32) fcum_item(bx, (const float*)(big + B_FL), args.in[(17) + z] + l * 8, (float*)(ws + WS_FC), (LAS float*)l3, tid, lane, wave);
                for (int it = bx; it < 2048; it += G)
                    lru_item<0>(it, (const bf16*)(big + B_AX), (bf16*)(big + B_AY), args.in[(7) + z] + (size_t)l * 2048, args.in[(8) + z] + l * 512, args.in[(9) + z] + (size_t)l * 32768, args.in[(10) + z] + l * 512,
                                args.in[(11) + z] + (size_t)l * 32768, args.in[(12) + z] + l * 512, args.in[(13) + z] + l * 512, (float*)(ws + WS_LRUS), (const float*)(ws + WS_LRUC), l3, tid);
                for (int it = bx; it < 2048; it += G)
                    gla_delta_item(it, (const bf16*)(big + B_GK), (const bf16*)(big + B_GV), (const float*)(big + B_LOW), args.in[(14) + z] + (size_t)l * 4096, args.in[(15) + z] + l * 256,
                                   (float*)(big + B_GST), (float*)(ws + WS_EG), l3, tid);
            } else if (PH_ON(5) && s == 5) {
                gla_scan((float*)(big + B_GST), (const float*)(ws + WS_EG), gtid, nthr);
                lru_carry((const float*)(ws + WS_LRUS), (float*)(ws + WS_LRUC), gtid);
            } else if (PH_ON(6) && s == 6) {
                const attn_body::AttnTensors AT{(const attn_body::bf16*)(big + B_CQ), (const attn_body::bf16*)(big + B_CK), (const attn_body::bf16*)(big + B_CV), (attn_body::bf16*)(big + B_CQ), (const float*)(ws + WS_FC)};
                const attn_body::StaticOrder S(G, bx);
                if (SUB_ON(1)) attn_body::attn_phase<attn_body::StaticOrder>((char*)lds, AT, S);
                if (SUB_ON(2)) for (int it = bx; it < 2048; it += G)
                    lru_item<1>(it, (const bf16*)(big + B_AX), (bf16*)(big + B_AY), args.in[(7) + z] + (size_t)l * 2048, args.in[(8) + z] + l * 512, args.in[(9) + z] + (size_t)l * 32768, args.in[(10) + z] + l * 512,
                                args.in[(11) + z] + (size_t)l * 32768, args.in[(12) + z] + l * 512, args.in[(13) + z] + l * 512, (float*)(ws + WS_LRUS), (const float*)(ws + WS_LRUC), l3, tid);
                if (SUB_ON(3)) for (int it = bx; it < 1024; it += G)
                    gla_out_item(it, (const bf16*)(big + B_GQ), (bf16*)(big + B_GR), (const float*)(big + B_GST), args.in[(16) + z] + l * 512, l3, tid);
            } else if (PH_ON(7) && s == 7) {
#pragma unroll 1
                for (int j = 0; j < 3; ++j) {
#ifdef MK_DBG_BR
                    if (j != MK_DBG_BR) continue;
#endif
                    {
#ifdef MK_DBG_WG
                        pg8::Gemm g{XB, (const bf16*)(wsw + W_O), T_, 1024, 1024};
#else
                        pg8::Gemm g{XB, (const bf16*)(wsw + W_G) + (size_t)j * 1024 * 1024, T_, 1024, 1024};
#endif
                         pg8::StaticOrder S; S.init(T_, 1024, G, bx);
                        pg8::EpiSig E{(bf16*)(big + B_S), nullptr};
                        pg8::gemm_phase<pg8::EpiSig, pg8::StaticOrder, PG8_ALIGN, PG8_SP2>(l3, g, S, E); }
#ifdef MK_DBG_FENCE
                    asm volatile("s_waitcnt vmcnt(0)" ::: "memory"); __builtin_amdgcn_fence(__ATOMIC_RELEASE, "agent"); __builtin_amdgcn_fence(__ATOMIC_ACQUIRE, "agent"); __syncthreads();
#endif
#ifdef MK_DBG_SKIPB
                    if (z == 0) continue;
#endif
                    {   const bf16* Y = (const bf16*)(big + (j == 0 ? B_AY : (j == 1 ? B_GR : B_CQ)));
                        pg8::Gemm g{Y, (const bf16*)(wsw + W_BR) + (size_t)j * 1024 * 512, T_, 1024, 512}; pg8::StaticOrder S; S.init(T_, 1024, G, bx);
                        #ifdef MK_DBG_BR
                        pg8::EpiGateMul E{(const bf16*)(big + B_S), (bf16*)(big + B_P), 1};
#else
                        pg8::EpiGateMul E{(const bf16*)(big + B_S), (bf16*)(big + B_P), j == 0 ? 1 : 0};
#endif
                        pg8::gemm_phase<pg8::EpiGateMul, pg8::StaticOrder, PG8_ALIGN, PG8_SP2>(l3, g, S, E); }
                }
            } else if (PH_ON(13) && s == 13) {
                if (SUB_ON(1)) {   pg8::Gemm g{XB, (const bf16*)(wsw + W_PG), T_, 1024, 1024}; pg8::StaticOrder S; S.init(T_, 1024, G, bx);
                    pg8::EpiSig E{(bf16*)(big + B_S2), args.in[(28) + z] + (size_t)l * 1024};
                    pg8::gemm_phase<pg8::EpiSig, pg8::StaticOrder, PG8_ALIGN, PG8_SP2>(l3, g, S, E); }
                if (SUB_ON(2)) {   pg8::Gemm g{(const bf16*)(big + B_PB), (const bf16*)(wsw + W_PP), T_, 1024, 256}; pg8::StaticOrder S; S.init(T_, 1024, G, bx);
                    pg8::EpiPle E{(const bf16*)(big + B_S2), X};
                    pg8::gemm_phase<pg8::EpiPle, pg8::StaticOrder, PG8_ALIGN, PG8_SP2>(l3, g, S, E); }
            }
        }
    }
}
template <int ONLY> __global__ void __launch_bounds__(NWAVES * 64, 2) mk_fwd(Args args) {
    extern __shared__ __attribute__((aligned(16))) unsigned char lds[];
    phase_body<ONLY>(args, args.ph_lo, lds);
}
#if !MK_MULTI
#define PHS(kind, ph) phase_body<kind>(args, ph, lds); grid.sync();
#define LAYER(b) PHS(0, b + 0) PHS(1, b + 1) PHS(2, b + 2) PHS(3, b + 3) PHS(4, b + 4) PHS(5, b + 5) PHS(6, b + 6) PHS(7, b + 7) PHS(1, b + 8) PHS(2, b + 9) PHS(0, b + 10) PHS(1, b + 11) PHS(2, b + 12) PHS(13, b + 13)
__global__ void __launch_bounds__(NWAVES * 64, 2) mk_fused(Args args) {
    extern __shared__ __attribute__((aligned(16))) unsigned char lds[];
    cg::grid_group grid = cg::this_grid();
    PHS(100, 0)
    LAYER(1) PHS(2, 15)
    LAYER(16) phase_body<2>(args, 30, lds);
}
#endif

template <int K> static bool mk_prep() { return hipFuncSetAttribute((const void*)mk_fwd<K>, hipFuncAttributeMaxDynamicSharedMemorySize, LDS_BYTES) == hipSuccess; }
extern "C" void kernel_launch(void* const* d_in, const int* in_sizes, int n_in, void* d_out, int out_size, void* d_ws, size_t ws_size, hipStream_t stream) {
    static int grid = 0;
    if (grid == 0) {
        if (n_in != 31 || in_sizes[0] != T_ * 1024 || out_size != T_ * 1024 || ws_size < WS_END) { fprintf(stderr, "kernel_launch: unexpected problem (n_in %d, out %d, ws %zu < %zu); nothing launched\n", n_in, out_size, ws_size, (size_t)WS_END); grid = -1; return; }
        int dev = 0, cus = 0;
        if (hipGetDevice(&dev) != hipSuccess || hipDeviceGetAttribute(&cus, hipDeviceAttributeMultiprocessorCount, dev) != hipSuccess) { grid = -1; return; }
#if MK_MULTI
        const bool ok = mk_prep<100>() && mk_prep<0>() && mk_prep<1>() && mk_prep<2>() && mk_prep<3>() && mk_prep<4>() && mk_prep<5>() && mk_prep<6>() && mk_prep<7>() && mk_prep<13>();
#else
        const bool ok = hipFuncSetAttribute((const void*)mk_fused, hipFuncAttributeMaxDynamicSharedMemorySize, LDS_BYTES) == hipSuccess;
#endif
        if (!ok) { fprintf(stderr, "kernel_launch: hipFuncSetAttribute failed\n"); grid = -1; return; }
        (void)hipGetLastError();
        grid = cus;
        if (grid != 256) { fprintf(stderr, "kernel_launch: built for 256 CUs, found %d; nothing launched\n", cus); grid = -1; return; }
    }
    if (grid < 0) return;
#ifdef MK_DBG_MEMSET
    hipMemsetAsync(d_ws, 0, WS_END, stream);
#endif
    Args a{};
    for (int i = 0; i < 31; ++i) a.in[i] = (const float*)d_in[i];
    a.out = (float*)d_out; a.ws = (unsigned char*)d_ws;
#if MK_MULTI
#ifndef MK_STOP
#define MK_STOP NPHASE
#endif
    for (int ph = 0; ph < MK_STOP; ++ph) { a.ph_lo = ph; a.ph_hi = ph + 1;
        const int s = ph == 0 ? -1 : (ph - 1) % 15; const dim3 g(grid), b(NWAVES * 64);
        if (s < 0) hipLaunchKernelGGL(mk_fwd<100>, g, b, LDS_BYTES, stream, a);
        else if (s == 0 || s == 10) hipLaunchKernelGGL(mk_fwd<0>, g, b, LDS_BYTES, stream, a);
        else if (s == 1 || s == 11 || s == 8) hipLaunchKernelGGL(mk_fwd<1>, g, b, LDS_BYTES, stream, a);
        else if (s == 2 || s == 9 || s == 12 || s == 14) hipLaunchKernelGGL(mk_fwd<2>, g, b, LDS_BYTES, stream, a);
        else if (s == 3) hipLaunchKernelGGL(mk_fwd<3>, g, b, LDS_BYTES, stream, a);
        else if (s == 4) hipLaunchKernelGGL(mk_fwd<4>, g, b, LDS_BYTES, stream, a);
        else if (s == 5) hipLaunchKernelGGL(mk_fwd<5>, g, b, LDS_BYTES, stream, a);
        else if (s == 6) hipLaunchKernelGGL(mk_fwd<6>, g, b, LDS_BYTES, stream, a);
        else if (s == 7) hipLaunchKernelGGL(mk_fwd<7>, g, b, LDS_BYTES, stream, a);
        else hipLaunchKernelGGL(mk_fwd<13>, g, b, LDS_BYTES, stream, a); }
#else
    a.ph_lo = 0; a.ph_hi = NPHASE; void* kargs[] = {&a};
    hipError_t e = hipLaunchCooperativeKernel((const void*)mk_fused, dim3(grid), dim3(NWAVES * 64), kargs, LDS_BYTES, stream);
    if (e != hipSuccess) fprintf(stderr, "kernel_launch: cooperative launch failed: %s\n", hipGetErrorString(e));
#endif
}
```

```cpp
#define MK_MULTI 0
#include <hip/hip_runtime.h>
#include <hip/hip_cooperative_groups.h>
namespace cg = cooperative_groups;
#include <cstdio>
#include <cstdint>
namespace pg8 {
#define PG8_LAS __attribute__((address_space(3)))
typedef unsigned short bf16_t;
typedef short bf16x8 __attribute__((ext_vector_type(8)));
typedef float f32x4 __attribute__((ext_vector_type(4)));
typedef unsigned u32x4 __attribute__((ext_vector_type(4)));
constexpr int BM = 256, BK = 64, HALF = 128, HTB = HALF * BK * 2  , STAGE_BYTES = 8 * HTB, NXCD = 8, WGM = 8;

__host__ __device__ __forceinline__ int lds_byte(int r, int c) { const int st = (r >> 4) * 2 + (c >> 5), rr = r & 15, cc = c & 31, ob = rr * 64 + cc * 2; return st * 1024 + (ob ^ (((ob >> 9) & 1) << 5)); }
__host__ __device__ __forceinline__ void stage_rc(int b, int& R, int& C) { const int st = b / 1024, sb = b % 1024, swz = sb ^ (((sb >> 9) & 1) << 5); R = (st >> 1) * 16 + swz / 64; C = (st & 1) * 32 + (swz % 64) / 2; }
__host__ __device__ __forceinline__ int perm32(int rho) { const int n = rho >> 4, i = rho & 15; return 8 * (i >> 2) + 4 * n + (i & 3); }

struct Unit { int pm, pn; };
struct Gemm { const bf16_t* A; const bf16_t* Bt; int M, N, K; };

struct StaticOrder {
    int nM, nN, nwg, G, c;
    __host__ __device__ void init(int M, int N, int G_, int c_) { nM = M / BM; nN = N / BM; nwg = nM * nN; G = G_; c = c_; }
    __host__ __device__ bool next(int i, Unit& u) const {
        const int L = i * G + c; if (L >= nwg) return false;
        int wgid = (int)L; { const int q = nwg / NXCD, r = nwg % NXCD, xcd = wgid % NXCD, off = wgid / NXCD; wgid = (xcd < r ? xcd * (q + 1) : r * (q + 1) + (xcd - r) * q) + off; }
        const int nig = WGM * nN, gid = wgid / nig, fm = gid * WGM, gsz = (nM - fm) < WGM ? (nM - fm) : WGM;
        u.pm = fm + ((wgid % nig) % gsz); u.pn = (wgid % nig) / gsz; return true;
    }
    __device__ __forceinline__ void a_ready(const Unit&) const {}
    __device__ __forceinline__ void done(const Unit&) const {}
};

typedef float cvf2_t __attribute__((ext_vector_type(2))); typedef __bf16 cvb2_t __attribute__((ext_vector_type(2)));
__device__ __forceinline__ unsigned cvt_pk_bf16(float lo, float hi) { const cvf2_t v = {lo, hi}; const cvb2_t b = __builtin_convertvector(v, cvb2_t); return __builtin_bit_cast(unsigned, b); }
typedef float f32x2 __attribute__((ext_vector_type(2)));
__device__ __forceinline__ f32x2 gelu_pk(f32x2 v) {
    const f32x2 av = __builtin_elementwise_abs(v), d = av * 0.2316418882f + 1.0f;
    f32x2 t; t.x = __builtin_amdgcn_rcpf(d.x); t.y = __builtin_amdgcn_rcpf(d.y);
    f32x2 q = t * 0.5307027145f + (-0.7265760135f); q = q * t + 0.7107068705f; q = q * t + (-0.142248368f); q = q * t + 0.127414796f; q = q * t;
    const f32x2 s = (v * v) * (-0.72134752044f);
    f32x2 e; e.x = __builtin_amdgcn_exp2f(s.x); e.y = __builtin_amdgcn_exp2f(s.y);
    const f32x2 m = v * (q * e), r = v - m;
    f32x2 o; o.x = v.x < 0.f ? m.x : r.x; o.y = v.y < 0.f ? m.y : r.y; return o;
}

template <int ACT  > struct EpiBf16 {
    static constexpr bool PERM = true, AFTER_DRAIN = false; static_assert(ACT == 0 || ACT == 1, "EpiBf16: ACT is 0 (none) or 1 (gelu_pk)");
    bf16_t* O; int ldc; const float* bias; int split_cols; size_t split_stride; float scale0;
    __device__ __forceinline__ void operator()(const f32x4 (&acc)[2][2][4][2], const Unit& u, int wr, int wc, int fr, int fq) const {
        const int row0 = u.pm * BM + wr * 64 + fr; int colt = u.pn * BM; bf16_t* base = O;
        float sc = 1.f; if (split_cols) { const int t = colt / split_cols; base += (size_t)t * split_stride; colt -= t * split_cols; if (t == 0) sc = scale0; }
        const int col0 = colt + wc * 32 + 8 * fq, bcol0 = u.pn * BM + wc * 32 + 8 * fq;
        f32x4 bv[2][2];
#pragma unroll
        for (int bj = 0; bj < 2; ++bj)
#pragma unroll
            for (int n = 0; n < 2; ++n) bv[bj][n] = bias ? *(const f32x4*)(bias + bcol0 + bj * HALF + 4 * n) : (f32x4){0.f, 0.f, 0.f, 0.f};
#pragma unroll
        for (int ai = 0; ai < 2; ++ai)
#pragma unroll
            for (int m = 0; m < 4; ++m) { bf16_t* rowp = base + (size_t)(row0 + ai * HALF + m * 16) * ldc + col0;
#pragma unroll
                for (int bj = 0; bj < 2; ++bj) { f32x4 v0 = acc[ai][bj][m][0] + bv[bj][0], v1 = acc[ai][bj][m][1] + bv[bj][1];
                    if (ACT == 1) { f32x2 a = gelu_pk((f32x2){v0[0], v0[1]}), b = gelu_pk((f32x2){v0[2], v0[3]}), c = gelu_pk((f32x2){v1[0], v1[1]}), d = gelu_pk((f32x2){v1[2], v1[3]});
                        v0 = (f32x4){a.x, a.y, b.x, b.y}; v1 = (f32x4){c.x, c.y, d.x, d.y}; }
                    v0 = v0 * sc; v1 = v1 * sc; u32x4 w; w.x = cvt_pk_bf16(v0[0], v0[1]); w.y = cvt_pk_bf16(v0[2], v0[3]); w.z = cvt_pk_bf16(v1[0], v1[1]); w.w = cvt_pk_bf16(v1[2], v1[3]);
                    *(u32x4*)(rowp + bj * HALF) = w; } }
    }
};

constexpr float MK_ALPHA = 1.41421356237309515f;
__device__ __forceinline__ float sigm(float x) { return __builtin_amdgcn_rcpf(1.0f + __builtin_amdgcn_exp2f(-1.4426950408889634f * x)); }
__device__ __forceinline__ float bf2f(unsigned short h) { return __uint_as_float(((unsigned)h) << 16); }
struct EpiSwiglu {
    static constexpr bool PERM = true, AFTER_DRAIN = false;
    bf16_t* H; int ldh;
    __device__ __forceinline__ void operator()(const f32x4 (&acc)[2][2][4][2], const Unit& u, int wr, int wc, int fr, int fq) const {
        const int row0 = u.pm * BM + wr * 64 + fr, col0 = u.pn * HALF + wc * 32 + 8 * fq;
#pragma unroll
        for (int ai = 0; ai < 2; ++ai)
#pragma unroll
            for (int m = 0; m < 4; ++m) { bf16_t* rowp = H + (size_t)(row0 + ai * HALF + m * 16) * ldh + col0;
                float h[8];
#pragma unroll
                for (int n = 0; n < 2; ++n)
#pragma unroll
                    for (int i = 0; i < 4; ++i) { const float g = acc[ai][0][m][n][i], up = acc[ai][1][m][n][i]; h[4 * n + i] = g * sigm(g) * up; }
                u32x4 w; w.x = cvt_pk_bf16(h[0], h[1]); w.y = cvt_pk_bf16(h[2], h[3]); w.z = cvt_pk_bf16(h[4], h[5]); w.w = cvt_pk_bf16(h[6], h[7]);
                *(u32x4*)rowp = w; }
    }
};
struct EpiResid {
    static constexpr bool PERM = true, AFTER_DRAIN = false;
    float* X; float s;
    __device__ __forceinline__ void operator()(const f32x4 (&acc)[2][2][4][2], const Unit& u, int wr, int wc, int fr, int fq) const {
        const int row0 = u.pm * BM + wr * 64 + fr, col0 = u.pn * BM + wc * 32 + 8 * fq;
#pragma unroll
        for (int ai = 0; ai < 2; ++ai)
#pragma unroll
            for (int m = 0; m < 4; ++m) { float* rowp = X + (size_t)(row0 + ai * HALF + m * 16) * 1024 + col0;
#pragma unroll
                for (int bj = 0; bj < 2; ++bj)
#pragma unroll
                    for (int n = 0; n < 2; ++n) { f32x4* p = (f32x4*)(rowp + bj * HALF + 4 * n); const f32x4 v = *p; *p = v * MK_ALPHA + acc[ai][bj][m][n] * s; } }
    }
};
struct EpiMixIn {
    static constexpr bool PERM = true, AFTER_DRAIN = false;
    bf16_t* big; float* low; float* fl; float cq_scale;
    __device__ __forceinline__ void operator()(const f32x4 (&acc)[2][2][4][2], const Unit& u, int wr, int wc, int fr, int fq) const {
        const int pn = u.pn; const int row0 = u.pm * BM + wr * 64 + fr;
        if (pn < 16) {
            size_t off; int ld, co; float sc = 1.f;
            if (pn < 2)       { off = 0;                  ld = 512; co = pn * 256; }
            else if (pn < 4)  { off = (size_t)32 << 20;   ld = 512; co = (pn - 2) * 256; }
            else if (pn == 4) { off = (size_t)16 << 20;   ld = 256; co = 0; sc = 0.125f; }
            else if (pn == 5) { off = (size_t)24 << 20;   ld = 256; co = 0; }
            else if (pn < 8)  { off = (size_t)48 << 20;   ld = 512; co = (pn - 6) * 256; }
            else if (pn < 10) { off = (size_t)64 << 20;   ld = 512; co = (pn - 8) * 256; }
            else if (pn < 12) { off = (size_t)80 << 20;   ld = 512; co = (pn - 10) * 256; sc = cq_scale; }
            else if (pn < 14) { off = (size_t)96 << 20;   ld = 512; co = (pn - 12) * 256; }
            else              { off = (size_t)112 << 20;  ld = 512; co = (pn - 14) * 256; }
            bf16_t* base = big + off; const int col0 = co + wc * 32 + 8 * fq;
#pragma unroll
            for (int ai = 0; ai < 2; ++ai)
#pragma unroll
                for (int m = 0; m < 4; ++m) { bf16_t* rowp = base + (size_t)(row0 + ai * HALF + m * 16) * ld + col0;
#pragma unroll
                    for (int bj = 0; bj < 2; ++bj) { const f32x4 v0 = acc[ai][bj][m][0] * sc, v1 = acc[ai][bj][m][1] * sc;
                        u32x4 w; w.x = cvt_pk_bf16(v0[0], v0[1]); w.y = cvt_pk_bf16(v0[2], v0[3]); w.z = cvt_pk_bf16(v1[0], v1[1]); w.w = cvt_pk_bf16(v1[2], v1[3]);
                        *(u32x4*)(rowp + bj * HALF) = w; } }
        } else {
            if (wc == 0 && fq < 3) {
#pragma unroll
                for (int ai = 0; ai < 2; ++ai)
#pragma unroll
                    for (int m = 0; m < 4; ++m) { const size_t row = (size_t)(row0 + ai * HALF + m * 16);
                        float* dst = (fq < 2) ? (low + row * 16 + 8 * fq) : (fl + row * 8);
                        *(f32x4*)dst = acc[ai][0][m][0]; *(f32x4*)(dst + 4) = acc[ai][0][m][1]; }
            }
        }
    }
};
struct EpiSig {
    static constexpr bool PERM = true, AFTER_DRAIN = false;
    bf16_t* S; const float* bias;
    __device__ __forceinline__ void operator()(const f32x4 (&acc)[2][2][4][2], const Unit& u, int wr, int wc, int fr, int fq) const {
        const int row0 = u.pm * BM + wr * 64 + fr, col0 = u.pn * BM + wc * 32 + 8 * fq;
        f32x4 bv[2][2];
#pragma unroll
        for (int bj = 0; bj < 2; ++bj)
#pragma unroll
            for (int n = 0; n < 2; ++n) bv[bj][n] = bias ? *(const f32x4*)(bias + col0 + bj * HALF + 4 * n) : (f32x4){0.f, 0.f, 0.f, 0.f};
#pragma unroll
        for (int ai = 0; ai < 2; ++ai)
#pragma unroll
            for (int m = 0; m < 4; ++m) { bf16_t* rowp = S + (size_t)(row0 + ai * HALF + m * 16) * 1024 + col0;
#pragma unroll
                for (int bj = 0; bj < 2; ++bj) { const f32x4 v0 = acc[ai][bj][m][0] + bv[bj][0], v1 = acc[ai][bj][m][1] + bv[bj][1];
                    u32x4 w; w.x = cvt_pk_bf16(sigm(v0[0]), sigm(v0[1])); w.y = cvt_pk_bf16(sigm(v0[2]), sigm(v0[3])); w.z = cvt_pk_bf16(sigm(v1[0]), sigm(v1[1])); w.w = cvt_pk_bf16(sigm(v1[2]), sigm(v1[3]));
                    *(u32x4*)(rowp + bj * HALF) = w; } }
    }
};
struct EpiGateMul {
    static constexpr bool PERM = true, AFTER_DRAIN = false;
    const bf16_t* S; bf16_t* P; int first;
    __device__ __forceinline__ void operator()(const f32x4 (&acc)[2][2][4][2], const Unit& u, int wr, int wc, int fr, int fq) const {
        const int row0 = u.pm * BM + wr * 64 + fr, col0 = u.pn * BM + wc * 32 + 8 * fq;
#pragma unroll
        for (int ai = 0; ai < 2; ++ai)
#pragma unroll
            for (int m = 0; m < 4; ++m) { const size_t ro = (size_t)(row0 + ai * HALF + m * 16) * 1024 + col0;
#pragma unroll
                for (int bj = 0; bj < 2; ++bj) { const u32x4 sv = *(const u32x4*)(S + ro + bj * HALF); u32x4 pv = (u32x4){0u, 0u, 0u, 0u}; if (!first) pv = *(const u32x4*)(P + ro + bj * HALF);
                    float o[8];
#pragma unroll
                    for (int i = 0; i < 4; ++i) {
#ifdef MK_DBG_NOS
                        const unsigned sw = 0x3f803f80u, pw = pv[i];
#else
                        const unsigned sw = sv[i], pw = pv[i];
#endif
 const float a0 = acc[ai][bj][m][i >> 1][(i & 1) * 2], a1 = acc[ai][bj][m][i >> 1][(i & 1) * 2 + 1];
                        o[2 * i] = __uint_as_float(pw << 16) + __uint_as_float(sw << 16) * a0; o[2 * i + 1] = __uint_as_float(pw & 0xffff0000u) + __uint_as_float(sw & 0xffff0000u) * a1; }
                    u32x4 w; w.x = cvt_pk_bf16(o[0], o[1]); w.y = cvt_pk_bf16(o[2], o[3]); w.z = cvt_pk_bf16(o[4], o[5]); w.w = cvt_pk_bf16(o[6], o[7]);
                    *(u32x4*)(P + ro + bj * HALF) = w; }
                asm volatile("" ::: "memory"); }
    }
};
struct EpiPle {
    static constexpr bool PERM = true, AFTER_DRAIN = false;
    const bf16_t* S; float* X;
    __device__ __forceinline__ void operator()(const f32x4 (&acc)[2][2][4][2], const Unit& u, int wr, int wc, int fr, int fq) const {
        const int row0 = u.pm * BM + wr * 64 + fr, col0 = u.pn * BM + wc * 32 + 8 * fq;
#pragma unroll
        for (int ai = 0; ai < 2; ++ai)
#pragma unroll
            for (int m = 0; m < 4; ++m) { const size_t ro = (size_t)(row0 + ai * HALF + m * 16) * 1024 + col0;
#pragma unroll
                for (int bj = 0; bj < 2; ++bj) { const u32x4 sv = *(const u32x4*)(S + ro + bj * HALF);
#pragma unroll
                    for (int n = 0; n < 2; ++n) { f32x4* p = (f32x4*)(X + ro + bj * HALF + 4 * n); const f32x4 v = *p; f32x4 g;
                        g[0] = __uint_as_float(sv[2 * n] << 16); g[1] = __uint_as_float(sv[2 * n] & 0xffff0000u); g[2] = __uint_as_float(sv[2 * n + 1] << 16); g[3] = __uint_as_float(sv[2 * n + 1] & 0xffff0000u);
                        *p = v * MK_ALPHA + g * acc[ai][bj][m][n]; } }
                asm volatile("" ::: "memory"); }
    }
};
template <class Epi, class Sched, bool ALIGN_EPI = false, bool SP2 = false>
__device__ __forceinline__ void gemm_phase(PG8_LAS unsigned char* lds, const Gemm g, const Sched& S, const Epi& E) {
    int tid_ = threadIdx.x; asm volatile("" : "+v"(tid_)); const int tid = tid_, wid = __builtin_amdgcn_readfirstlane(tid >> 6), lane = tid & 63, wr = wid >> 2, wc = wid & 3, fr = lane & 15, fq = lane >> 4;
    const int K = g.K, nt = K / BK;
    unsigned voffA[2], voffB[2];
#pragma unroll
    for (int i = 0; i < 2; ++i) { int R, C; stage_rc(tid * 16 + i * 8192, R, C); const int Rb = Epi::PERM ? ((R & ~31) + perm32(R & 31)) : R;
        voffA[i] = (unsigned)(R * K + C) * 2u; voffB[i] = (unsigned)(Rb * K + C) * 2u; }
    const size_t kstep = (size_t)(BK * 2);
    const size_t hstep = (size_t)HALF * K * 2;
    const size_t tstep = 2 * hstep;
    const unsigned ldsw = (unsigned)wid * 1024u;
    const int aoff = lds_byte(wr * 64 + fr, fq * 8), boff = lds_byte(wc * 32 + fr, fq * 8);
#define PG8_SA(b, h) (((b) * 2 + (h)) * HTB)
#define PG8_SB(b, h) ((4 + (b) * 2 + (h)) * HTB)
#define PG8_STAGE(bufoff, gbase, voff) do { _Pragma("unroll") for (int _i = 0; _i < 2; ++_i) \
        __builtin_amdgcn_global_load_lds((const unsigned*)((const char*)(gbase) + (voff)[_i]), (PG8_LAS unsigned*)(lds + (bufoff) + ldsw + _i * 8192), 16, 0, 0); } while (0)
#define PG8_LDA(dst, b, h) do { _Pragma("unroll") for (int m = 0; m < 4; ++m) _Pragma("unroll") for (int k = 0; k < 2; ++k) dst[m][k] = *(const PG8_LAS bf16x8*)(lds + PG8_SA(b, h) + aoff + m * 2048 + k * 1024); } while (0)
#define PG8_LDB(dst, b, h) do { _Pragma("unroll") for (int n = 0; n < 2; ++n) _Pragma("unroll") for (int k = 0; k < 2; ++k) dst[n][k] = *(const PG8_LAS bf16x8*)(lds + PG8_SB(b, h) + boff + n * 2048 + k * 1024); } while (0)
#define PG8_MMA(ai, bj, At, Bt) do { __builtin_amdgcn_s_setprio(1); _Pragma("unroll") for (int m = 0; m < 4; ++m) _Pragma("unroll") for (int n = 0; n < 2; ++n) _Pragma("unroll") for (int k = 0; k < 2; ++k) \
        acc[ai][bj][m][n] = __builtin_amdgcn_mfma_f32_16x16x32_bf16(Bt[n][k], At[m][k], acc[ai][bj][m][n], 0, 0, 0); __builtin_amdgcn_s_setprio(0); } while (0)
#define PG8_WAIT_V(n) asm volatile("s_waitcnt vmcnt(" #n ")" ::: "memory")
#define PG8_WAIT_L(n) asm volatile("s_waitcnt lgkmcnt(" #n ")" ::: "memory")
#define PG8_BAR __builtin_amdgcn_s_barrier()
#define PG8_SCHED __builtin_amdgcn_sched_barrier(0)
    Unit cur, nxt; int ui = 0;
    if (!S.next(0, cur)) return;
    f32x4 acc[2][2][4][2];
#pragma unroll
    for (int a = 0; a < 2; ++a)
#pragma unroll
        for (int b = 0; b < 2; ++b)
#pragma unroll
            for (int m = 0; m < 4; ++m)
#pragma unroll
                for (int n = 0; n < 2; ++n) acc[a][b][m][n] = (f32x4){0.f, 0.f, 0.f, 0.f};
    bf16x8 At[4][2], B0[2][2], B1[2][2];
    const char* cA = (const char*)g.A + (size_t)cur.pm * tstep; const char* cB = (const char*)g.Bt + (size_t)cur.pn * tstep;
    S.a_ready(cur);
    if constexpr (SP2) {
        PG8_STAGE(PG8_SB(0, 0), cB, voffB); PG8_STAGE(PG8_SB(0, 1), cB + hstep, voffB); PG8_STAGE(PG8_SA(0, 0), cA, voffA); PG8_STAGE(PG8_SA(0, 1), cA + hstep, voffA);
        if (wr == 1) PG8_BAR;
        PG8_WAIT_V(2); PG8_BAR;
        PG8_STAGE(PG8_SB(1, 0), cB + kstep, voffB); PG8_STAGE(PG8_SA(1, 0), cA + kstep, voffA); PG8_STAGE(PG8_SB(1, 1), cB + hstep + kstep, voffB);
        PG8_WAIT_V(6); PG8_BAR;
    } else {
        PG8_STAGE(PG8_SB(0, 0), cB, voffB); PG8_STAGE(PG8_SA(0, 0), cA, voffA); PG8_STAGE(PG8_SB(0, 1), cB + hstep, voffB); PG8_STAGE(PG8_SA(0, 1), cA + hstep, voffA);
        if (wr == 1) PG8_BAR;
        PG8_WAIT_V(4); PG8_BAR;
        PG8_STAGE(PG8_SB(1, 0), cB + kstep, voffB); PG8_STAGE(PG8_SA(1, 0), cA + kstep, voffA); PG8_STAGE(PG8_SB(1, 1), cB + hstep + kstep, voffB);
        PG8_WAIT_V(6); PG8_BAR;
    }
    for (;;) {
        const bool has_next = S.next(ui + 1, nxt);
        const char* nA = has_next ? (const char*)g.A + (size_t)nxt.pm * tstep : cA; const char* nB = has_next ? (const char*)g.Bt + (size_t)nxt.pn * tstep : cB;
        for (int t = 0; t < nt; t += 2) {
            const bool last = (t == nt - 2);
            const char* a1 = cA + (size_t)(t + 1) * kstep;
            const char* a2 = last ? nA : cA + (size_t)(t + 2) * kstep; const char* b2 = last ? nB : cB + (size_t)(t + 2) * kstep;
            const char* a3 = a2 + kstep; const char* b3 = b2 + kstep;
            if (last && has_next) S.a_ready(nxt);
            if constexpr (SP2) {
            PG8_LDB(B0, 0, 0); PG8_LDB(B1, 0, 1); PG8_SCHED; PG8_LDA(At, 0, 0); PG8_STAGE(PG8_SA(1, 1), a1 + hstep, voffA);
            PG8_WAIT_V(8); PG8_WAIT_L(0); PG8_BAR; PG8_MMA(0, 0, At, B0); PG8_MMA(0, 1, At, B1); PG8_BAR; PG8_SCHED;
            PG8_LDA(At, 0, 1); PG8_STAGE(PG8_SB(0, 0), b2, voffB); PG8_STAGE(PG8_SB(0, 1), b2 + hstep, voffB); PG8_STAGE(PG8_SA(0, 0), a2, voffA);
            PG8_WAIT_V(8); PG8_WAIT_L(0); PG8_BAR; PG8_MMA(1, 0, At, B0); PG8_MMA(1, 1, At, B1); PG8_BAR; PG8_SCHED;
            PG8_LDB(B0, 1, 0); PG8_LDB(B1, 1, 1); PG8_SCHED; PG8_LDA(At, 1, 0); PG8_STAGE(PG8_SA(0, 1), a2 + hstep, voffA);
            PG8_WAIT_V(8); PG8_WAIT_L(0); PG8_BAR; PG8_MMA(0, 0, At, B0); PG8_MMA(0, 1, At, B1); PG8_BAR; PG8_SCHED;
            PG8_LDA(At, 1, 1); PG8_STAGE(PG8_SB(1, 0), b3, voffB); PG8_STAGE(PG8_SB(1, 1), b3 + hstep, voffB); PG8_STAGE(PG8_SA(1, 0), a3, voffA);
            PG8_WAIT_V(8); PG8_WAIT_L(0); PG8_BAR; PG8_MMA(1, 0, At, B0); PG8_MMA(1, 1, At, B1); PG8_BAR; PG8_SCHED;
            } else {
            PG8_LDB(B0, 0, 0); PG8_SCHED; PG8_LDA(At, 0, 0); PG8_STAGE(PG8_SA(1, 1), a1 + hstep, voffA);
            PG8_WAIT_L(8); PG8_BAR; PG8_WAIT_L(0); PG8_MMA(0, 0, At, B0); PG8_BAR; PG8_SCHED;
            PG8_LDB(B1, 0, 1); PG8_STAGE(PG8_SB(0, 0), b2, voffB);
            PG8_BAR; PG8_WAIT_L(0); PG8_MMA(0, 1, At, B1); PG8_BAR;
            PG8_LDA(At, 0, 1); PG8_STAGE(PG8_SA(0, 0), a2, voffA);
            PG8_BAR; PG8_WAIT_L(0); PG8_MMA(1, 0, At, B0); PG8_BAR; PG8_SCHED;
            PG8_STAGE(PG8_SB(0, 1), b2 + hstep, voffB);
            PG8_WAIT_V(6); PG8_BAR; PG8_MMA(1, 1, At, B1); PG8_BAR;
            PG8_LDB(B0, 1, 0); PG8_SCHED; PG8_LDA(At, 1, 0); PG8_STAGE(PG8_SA(0, 1), a2 + hstep, voffA);
            PG8_WAIT_L(8); PG8_BAR; PG8_WAIT_L(0); PG8_MMA(0, 0, At, B0); PG8_BAR; PG8_SCHED;
            PG8_LDB(B1, 1, 1); PG8_STAGE(PG8_SB(1, 0), b3, voffB);
            PG8_BAR; PG8_WAIT_L(0); PG8_MMA(0, 1, At, B1); PG8_BAR;
            PG8_LDA(At, 1, 1); PG8_STAGE(PG8_SA(1, 0), a3, voffA);
            PG8_BAR; PG8_WAIT_L(0); PG8_MMA(1, 0, At, B0); PG8_BAR; PG8_SCHED;
            PG8_STAGE(PG8_SB(1, 1), b3 + hstep, voffB);
            PG8_WAIT_V(6); PG8_BAR; PG8_MMA(1, 1, At, B1); PG8_BAR;
            }
        }
        if constexpr (ALIGN_EPI) { if (wr == 0) PG8_BAR; }
        if constexpr (!Epi::AFTER_DRAIN) { E(acc, cur, wr, wc, fr, fq); S.done(cur); }
        if (!has_next) break;
#pragma unroll
        for (int a = 0; a < 2; ++a)
#pragma unroll
            for (int b = 0; b < 2; ++b)
#pragma unroll
                for (int m = 0; m < 4; ++m)
#pragma unroll
                    for (int n = 0; n < 2; ++n) acc[a][b][m][n] = (f32x4){0.f, 0.f, 0.f, 0.f};
        cur = nxt; cA = nA; cB = nB; ++ui;
        if constexpr (ALIGN_EPI) { if (wr == 1) PG8_BAR; }
    }
    PG8_WAIT_V(0);
    if constexpr (!ALIGN_EPI) { if (wr == 0) PG8_BAR; }
    PG8_BAR;
    if constexpr (Epi::AFTER_DRAIN) { E.fused(acc, cur, wr, wc, fr, fq, lds, wid, lane); S.done(cur); }
#undef PG8_SA
#undef PG8_SB
#undef PG8_STAGE
#undef PG8_LDA
#undef PG8_LDB
#undef PG8_MMA
#undef PG8_WAIT_V
#undef PG8_WAIT_L
#undef PG8_BAR
#undef PG8_SCHED
}
}

#ifndef PG8_SP2
#define PG8_SP2 true
#endif
#ifndef PG8_ALIGN
#define PG8_ALIGN true
#endif

#include <hip/hip_bf16.h>
#include <cmath>
namespace attn_body {
using bf16=__hip_bfloat16;
using bf16x8=__attribute__((ext_vector_type(8)))short;
using s16x4=__attribute__((ext_vector_type(4)))short;
using f32x16=__attribute__((ext_vector_type(16)))float;
using u32x4=__attribute__((ext_vector_type(4)))unsigned;
using f32x4_t=__attribute__((ext_vector_type(4)))float;
constexpr int BATCH=4,NHEAD=8,SEQ=8192,D=64,DM=NHEAD*D;
constexpr int NW=8,QBLK=32,QB=QBLK*NW,KVBLK=64,NQB=SEQ/QB;
constexpr int ATTN_PITCH=DM, ATTN_UNIT_ROWS=QB;
__device__ __forceinline__ int crow(int r,int hi){return (r&3)+8*(r>>2)+4*hi;}
#define SBAR() __builtin_amdgcn_sched_barrier(0)
__device__ __forceinline__ void cmask(f32x16&p0,f32x16&p1,int jb,int qrel,int hi){
  const float NEG=-INFINITY; int kb=64*jb+4*hi;
  #pragma unroll
  for(int r=0;r<16;++r){int kv=kb+(r&3)+8*(r>>2); if(kv>qrel)p0[r]=NEG; if(kv+32>qrel)p1[r]=NEG;}
}

constexpr int NSLOT=3, SLOTB=8192;
constexpr int LDS_K=0, LDS_V=NSLOT*SLOTB, LDS_WS=2*NSLOT*SLOTB, LDS_OST=LDS_WS+NW*64*4, LDS_F=LDS_OST+NW*4096, LDS_BYTES=LDS_F+SEQ*4;
constexpr float C2=0.125f*1.4426950408889634f;
__device__ __forceinline__ void glds16(const void*gsrc,unsigned lds_dst){unsigned keep;
  asm volatile("s_mov_b32 %0, m0\n\ts_mov_b32 m0, %2\n\ts_nop 0\n\tglobal_load_lds_dwordx4 %1, off\n\ts_mov_b32 m0, %0":"=&s"(keep):"v"(gsrc),"s"(lds_dst):"memory");}
__device__ __forceinline__ float max3f(float a,float b,float c){float r;asm("v_max3_f32 %0, %1, %2, %3":"=v"(r):"v"(a),"v"(b),"v"(c));return r;}
__device__ __forceinline__ float max2f(float a,float b){float r;asm("v_max_f32_e32 %0, %1, %2":"=v"(r):"v"(a),"v"(b));return r;}
__device__ __forceinline__ float fadd_s(float a,float b){float r;asm("v_add_f32_e32 %0, %1, %2":"=v"(r):"v"(a),"v"(b));return r;}
__device__ __forceinline__ float fsub_s(float a,float b){float r;asm("v_sub_f32_e32 %0, %1, %2":"=v"(r):"v"(a),"v"(b));return r;}
typedef float f32x2_t __attribute__((ext_vector_type(2))); typedef __bf16 bf16x2_t __attribute__((ext_vector_type(2)));
__device__ __forceinline__ unsigned cvtpk_s(float lo,float hi){f32x2_t v={lo,hi};bf16x2_t b=__builtin_convertvector(v,bf16x2_t);return __builtin_bit_cast(unsigned,b);}
#define WAIT_BAR(N) asm volatile("s_waitcnt vmcnt(" #N ") lgkmcnt(0)\n\ts_barrier":::"memory")

__device__ __forceinline__ void qkt(f32x16&p0,f32x16&p1,const char*Kslot,const bf16x8*qr,const f32x16&negm,int r32,int hi){
  const char*kb=Kslot+hi*1024+r32*16;
  #pragma unroll
  for(int d0=0;d0<4;++d0){
    const bf16x8 b0=*reinterpret_cast<const bf16x8*>(kb+d0*2048);
    const bf16x8 b1=*reinterpret_cast<const bf16x8*>(kb+d0*2048+512);
    {p0=__builtin_amdgcn_mfma_f32_32x32x16_bf16(b0,qr[d0],p0,0,0,0);p1=__builtin_amdgcn_mfma_f32_32x32x16_bf16(b1,qr[d0],p1,0,0,0);}}
}
typedef __attribute__((address_space(3))) const char* lds_cptr;
typedef short v4i16_t __attribute__((ext_vector_type(4)));
__device__ __forceinline__ void kload8(bf16x8*kf,lds_cptr kp){
  kf[0]=*(const __attribute__((address_space(3))) bf16x8*)(kp);      kf[1]=*(const __attribute__((address_space(3))) bf16x8*)(kp+512);
  kf[2]=*(const __attribute__((address_space(3))) bf16x8*)(kp+2048); kf[3]=*(const __attribute__((address_space(3))) bf16x8*)(kp+2560);
  kf[4]=*(const __attribute__((address_space(3))) bf16x8*)(kp+4096); kf[5]=*(const __attribute__((address_space(3))) bf16x8*)(kp+4608);
  kf[6]=*(const __attribute__((address_space(3))) bf16x8*)(kp+6144); kf[7]=*(const __attribute__((address_space(3))) bf16x8*)(kp+6656);
}
__device__ __forceinline__ void kload2(bf16x8*kf,lds_cptr kp,int j){ kf[2*j]=*(const __attribute__((address_space(3))) bf16x8*)(kp+j*2048); kf[2*j+1]=*(const __attribute__((address_space(3))) bf16x8*)(kp+j*2048+512); }
__device__ __forceinline__ s16x4 vtr(lds_cptr p){ return __builtin_bit_cast(s16x4,__builtin_amdgcn_ds_read_tr16_b64_v4i16((__attribute__((address_space(3))) v4i16_t*)p)); }
__device__ __forceinline__ float rowmax(const f32x16&p0,const f32x16&p1){
  float a=max3f(p0[0],p0[1],p1[0]),b=max3f(p0[2],p0[3],p1[1]);a=max3f(a,p1[2],p1[3]);
  #pragma unroll
  for(int r=4;r<16;r+=4){a=max3f(a,p0[r],p0[r+1]);b=max3f(b,p0[r+2],p0[r+3]);a=max3f(a,p1[r],p1[r+1]);b=max3f(b,p1[r+2],p1[r+3]);}
  const float m=max2f(a,b);
  auto rr=__builtin_amdgcn_permlane32_swap(__float_as_uint(m),__float_as_uint(m),false,false);
  return max2f(__uint_as_float(rr[0]),__uint_as_float(rr[1]));
}
__device__ __forceinline__ void pv(f32x16*o,int vb,bf16x8 pa0,bf16x8 pa1,bf16x8 pa2,bf16x8 pa3){
  #pragma unroll
  for(int d0=0;d0<2;++d0){s16x4 lo[4],hi[4];
    #pragma unroll
    for(int ks=0;ks<4;++ks){
      asm volatile("ds_read_b64_tr_b16 %0,%1 offset:%c2":"=&v"(lo[ks]):"v"(vb),"i"(d0*4096+ks*1024):"memory");
      asm volatile("ds_read_b64_tr_b16 %0,%1 offset:%c2":"=&v"(hi[ks]):"v"(vb),"i"(d0*4096+ks*1024+512):"memory");}
    asm volatile("s_waitcnt lgkmcnt(0)":::"memory");SBAR();
    #define PK(k) (bf16x8){lo[k][0],lo[k][1],lo[k][2],lo[k][3],hi[k][0],hi[k][1],hi[k][2],hi[k][3]}
    o[d0]=__builtin_amdgcn_mfma_f32_32x32x16_bf16(pa0,PK(0),o[d0],0,0,0);
    o[d0]=__builtin_amdgcn_mfma_f32_32x32x16_bf16(pa1,PK(1),o[d0],0,0,0);
    o[d0]=__builtin_amdgcn_mfma_f32_32x32x16_bf16(pa2,PK(2),o[d0],0,0,0);
    o[d0]=__builtin_amdgcn_mfma_f32_32x32x16_bf16(pa3,PK(3),o[d0],0,0,0);
    #undef PK
  }
}

#ifndef ATTN_STORE16
#define ATTN_STORE16(p,v) (*(u32x4*)(p)=(v))
#endif
template<int THRL> __device__ __forceinline__ void attn_unit(int b,int h,int qb,const bf16*Q,const bf16*__restrict__ K,const bf16*__restrict__ V,bf16*O,const float*__restrict__ Fc,const int toff,char*shm){
  int tid_=threadIdx.x; asm volatile("":"+v"(tid_)); const int tid=tid_,lane=tid&63,r32=lane&31,hi=lane>>5; const int wid=__builtin_amdgcn_readfirstlane(tid>>6);
  const long rowbase=(long)b*SEQ; const int q0=qb*QB;
  const bf16*Qw=Q+(rowbase+q0+wid*QBLK)*DM+h*D;
  const bf16*Kh=K+(rowbase+(long)toff*KVBLK)*DM+h*D,*Vh=V+(rowbase+(long)toff*KVBLK)*DM+h*D;
  const unsigned lds0=(unsigned)(uintptr_t)shm;
  float*wsf=(float*)(shm+LDS_WS)+wid*64;
  const bf16*ksrc=Kh+(long)lane*DM+wid*8;
  const bf16*vsrc=Vh+(long)(16*(wid&3)+(lane>>2))*DM+(wid>>2)*32+(lane&3)*8;
  const unsigned kdst=lds0+LDS_K+wid*1024, vdst=lds0+LDS_V+wid*1024;
  #define DMA_K(t,slot) glds16(ksrc+(long)(t)*KVBLK*DM,(unsigned)__builtin_amdgcn_readfirstlane(kdst+(slot)))
  #define DMA_V(t,slot) glds16(vsrc+(long)(t)*KVBLK*DM,(unsigned)__builtin_amdgcn_readfirstlane(vdst+(slot)))
  const int vb0=(int)(lds0+LDS_V)+((lane>>4)&1)*32+(lane&3)*8+(4*hi+((lane&15)>>2))*64;
  const char*Kbase=shm+LDS_K; bf16x8 kf[8];
  const lds_cptr shm3=(lds_cptr)shm; const lds_cptr kp0=shm3+LDS_K+hi*1024+r32*16; const lds_cptr vp0=shm3+LDS_V+((lane>>4)&1)*32+(lane&3)*8+(4*hi+((lane&15)>>2))*64;
  const int NT=(q0+QB)/KVBLK-toff;
  { const int nf4=(q0+QB)>>2; __attribute__((address_space(3))) f32x4_t* ft=(__attribute__((address_space(3))) f32x4_t*)((lds_cptr)shm+LDS_F); const f32x4_t* fs=(const f32x4_t*)Fc; for(int i=toff*16+tid;i<nf4;i+=NW*64)ft[i]=fs[i]; }
  const float fq2=Fc[q0+wid*QBLK+r32];
  DMA_K(0,0);DMA_V(0,0);DMA_K(1,SLOTB);
  bf16x8 qr[4];
  #pragma unroll
  for(int d0=0;d0<4;++d0)qr[d0]=*reinterpret_cast<const bf16x8*>(&Qw[(long)r32*DM+d0*16+hi*8]);
  float mhat=-fq2,l_reg=0.f;f32x16 o[2];o[0]=f32x16{};o[1]=f32x16{};const f32x16 negm=f32x16{};
  const __attribute__((address_space(3))) float* fkb=(const __attribute__((address_space(3))) float*)((lds_cptr)shm+LDS_F)+4*hi+toff*64;
  #define FBINIT(P0,P1,t) do{ const __attribute__((address_space(3))) float* fp_=fkb+(t)*64; const float nm_=-mhat; _Pragma("unroll") for(int j_=0;j_<4;++j_){ const f32x4_t a_=*(const __attribute__((address_space(3))) f32x4_t*)(fp_+8*j_), b_=*(const __attribute__((address_space(3))) f32x4_t*)(fp_+32+8*j_); \
      P0[4*j_]=nm_-a_[0];P0[4*j_+1]=nm_-a_[1];P0[4*j_+2]=nm_-a_[2];P0[4*j_+3]=nm_-a_[3]; P1[4*j_]=nm_-b_[0];P1[4*j_+1]=nm_-b_[1];P1[4*j_+2]=nm_-b_[2];P1[4*j_+3]=nm_-b_[3]; } }while(0)
  const int qrel=wid*QBLK+r32;
  #define CMASK(P0,P1,t) do{int jb_=(t)-(NT-4); if(jb_>=0)cmask(P0,P1,jb_,qrel,hi);}while(0)
  bool resc=false;
  #define START(P0,P1) do{ const float rm=rowmax(P0,P1); resc=false; \
    { const float dl=rm; mhat=fadd_s(mhat,dl); \
      _Pragma("unroll") for(int r=0;r<16;++r){P0[r]=fsub_s(P0[r],dl);P1[r]=fsub_s(P1[r],dl);} \
      } \
    _Pragma("unroll") for(int r=0;r<16;++r)P0[r]=__builtin_amdgcn_exp2f(P0[r]); }while(0)
  #define RESC() do{ if(resc){ asm volatile("s_waitcnt lgkmcnt(0)":::"memory"); \
      _Pragma("unroll") for(int d_=0;d_<2;++d_) _Pragma("unroll") for(int r=0;r<16;++r)o[d_][r]*=wsf[crow(r,hi)]; } }while(0)
  f32x16 pA0,pA1,pB0,pB1;
  int sl_prev=0,sl_cur=0,sl_next=SLOTB;
  #define ROT() do{sl_prev=sl_cur;sl_cur=sl_next;sl_next=(sl_next==(NSLOT-1)*SLOTB)?0:sl_next+SLOTB;}while(0)
  DMA_K(2,2*SLOTB);
  WAIT_BAR(3);
  FBINIT(pA0,pA1,0);
  qkt(pA0,pA1,Kbase,qr,negm,r32,hi);asm volatile("s_nop 15\n\ts_nop 7":"+v"(pA0),"+v"(pA1));CMASK(pA0,pA1,0);
  START(pA0,pA1);
  _Pragma("unroll") for(int r=0;r<16;++r)pA1[r]=__builtin_amdgcn_exp2f(pA1[r]);
  WAIT_BAR(0);
  DMA_K(3,0);DMA_V(1,SLOTB);
  ROT();
  kload8(kf,kp0+sl_cur);
  WAIT_BAR(2);
  s16x4 vlo[8],vhi[8]; u32x4 pw0,pw1,pw2,pw3;
  #define PKW(P,B) cvtpk_s(P[B],P[B+1])
  #define PAF(k) __builtin_bit_cast(bf16x8,pw##k)
  #define VFR(i) (bf16x8){vlo[i][0],vlo[i][1],vlo[i][2],vlo[i][3],vhi[i][0],vhi[i][1],vhi[i][2],vhi[i][3]}
  #define PIN(x) asm volatile("":"+v"(x))
  #define MX3(a,b,c) __builtin_fmaxf(__builtin_fmaxf((a),(b)),(c))
  #define GAPA(MF,A0,A1,A2,A3,W0,W1,PW) do{ MF; sacc+=A0; sacc+=A1; sacc+=A2; sacc+=A3; PIN(sacc); W0; W1; PIN(PW); SBAR(); }while(0)
  #define EX(v) __builtin_amdgcn_exp2f(v)
  #define GAPB(MF,X,B) do{ MF; X[B]=EX(X[B]); X[B+1]=EX(X[B+1]); X[B+2]=EX(X[B+2]); X[B+3]=EX(X[B+3]); PIN(X); SBAR(); }while(0)
  #define VRD(i) do{ vlo[i]=vtr(vp_+(((i)>>2)*4096+((i)&3)*1024)); vhi[i]=vtr(vp_+(((i)>>2)*4096+((i)&3)*1024+512)); }while(0)
  #define KRD(G,j) do{ if(G){ kload2(kf,kp0+sl_next,j); SBAR(); } }while(0)
  #define STEP(C0,C1,P0,P1,t,GK,GV,GL) do{ SBAR(); FBINIT(C0,C1,t); SBAR(); \
    const lds_cptr vp_=vp0+sl_prev; \
    VRD(0); SBAR(); float sacc=(P0[0]+P0[1]); \
    GAPA(C0=__builtin_amdgcn_mfma_f32_32x32x16_bf16(kf[0],qr[0],C0,0,0,0), P0[2],P0[3],P0[4],P0[5],     pw0[0]=PKW(P0,0), pw0[1]=PKW(P0,2), pw0); \
    VRD(4); SBAR(); GAPA(C1=__builtin_amdgcn_mfma_f32_32x32x16_bf16(kf[1],qr[0],C1,0,0,0), P0[6],P0[7],P0[8],P0[9],     pw0[2]=PKW(P0,4), pw0[3]=PKW(P0,6), pw0); \
    VRD(1); SBAR(); GAPA(C0=__builtin_amdgcn_mfma_f32_32x32x16_bf16(kf[2],qr[1],C0,0,0,0),   P0[10],P0[11],P0[12],P0[13], pw1[0]=PKW(P0,8), pw1[1]=PKW(P0,10), pw1); \
    VRD(5); SBAR(); GAPA(C1=__builtin_amdgcn_mfma_f32_32x32x16_bf16(kf[3],qr[1],C1,0,0,0),   P0[14],P0[15],P1[0],P1[1],   pw1[2]=PKW(P0,12),pw1[3]=PKW(P0,14), pw1); \
    VRD(2); SBAR(); GAPA(C0=__builtin_amdgcn_mfma_f32_32x32x16_bf16(kf[4],qr[2],C0,0,0,0),   P1[2],P1[3],P1[4],P1[5],     pw2[0]=PKW(P1,0), pw2[1]=PKW(P1,2), pw2); \
    VRD(6); SBAR(); GAPA(C1=__builtin_amdgcn_mfma_f32_32x32x16_bf16(kf[5],qr[2],C1,0,0,0),   P1[6],P1[7],P1[8],P1[9],     pw2[2]=PKW(P1,4), pw2[3]=PKW(P1,6), pw2); \
    VRD(3); SBAR(); GAPA(C0=__builtin_amdgcn_mfma_f32_32x32x16_bf16(kf[6],qr[3],C0,0,0,0),   P1[10],P1[11],P1[12],P1[13], pw3[0]=PKW(P1,8), pw3[1]=PKW(P1,10), pw3); \
    VRD(7); SBAR(); GAPA(C1=__builtin_amdgcn_mfma_f32_32x32x16_bf16(kf[7],qr[3],C1,0,0,0),   P1[14],P1[15],0.f,0.f,       pw3[2]=PKW(P1,12),pw3[3]=PKW(P1,14), pw3); \
    l_reg+=sacc; \
    if(GK){DMA_K((t)+3,sl_cur);} if(GV){DMA_V((t)+1,sl_next);} \
    CMASK(C0,C1,t); \
    { float a=MX3(C0[0],C0[1],C1[0]),b=MX3(C0[2],C0[3],C1[1]); a=MX3(a,C1[2],C1[3]); \
      _Pragma("unroll") for(int r=4;r<16;r+=4){a=MX3(a,C0[r],C0[r+1]);b=MX3(b,C0[r+2],C0[r+3]);a=MX3(a,C1[r],C1[r+1]);b=MX3(b,C1[r+2],C1[r+3]);} \
      float rm=__builtin_fmaxf(a,b); { auto rr=__builtin_amdgcn_permlane32_swap(__float_as_uint(rm),__float_as_uint(rm),false,false); rm=__builtin_fmaxf(__uint_as_float(rr[0]),__uint_as_float(rr[1])); } \
      resc=false; \
      if(__builtin_expect(__any(rm>(float)THRL),0)){ const float dl=__builtin_fmaxf(rm,0.f); mhat+=dl; \
        _Pragma("unroll") for(int r=0;r<16;++r){C0[r]-=dl;C1[r]-=dl;} \
        const float f=__builtin_amdgcn_exp2f(-dl); l_reg*=f; if(hi==0)wsf[r32]=f; resc=true; } } \
    SBAR(); \
    GAPB(o[0]=__builtin_amdgcn_mfma_f32_32x32x16_bf16(PAF(0),VFR(0),o[0],0,0,0), C0,0); \
    GAPB(o[1]=__builtin_amdgcn_mfma_f32_32x32x16_bf16(PAF(0),VFR(4),o[1],0,0,0), C0,4); \
    KRD(GL,0); GAPB(o[0]=__builtin_amdgcn_mfma_f32_32x32x16_bf16(PAF(1),VFR(1),o[0],0,0,0), C0,8); \
    KRD(GL,1); GAPB(o[1]=__builtin_amdgcn_mfma_f32_32x32x16_bf16(PAF(1),VFR(5),o[1],0,0,0), C0,12); \
    KRD(GL,2); GAPB(o[0]=__builtin_amdgcn_mfma_f32_32x32x16_bf16(PAF(2),VFR(2),o[0],0,0,0), C1,0); \
    KRD(GL,3); GAPB(o[1]=__builtin_amdgcn_mfma_f32_32x32x16_bf16(PAF(2),VFR(6),o[1],0,0,0), C1,4); \
    GAPB(o[0]=__builtin_amdgcn_mfma_f32_32x32x16_bf16(PAF(3),VFR(3),o[0],0,0,0), C1,8); \
    GAPB(o[1]=__builtin_amdgcn_mfma_f32_32x32x16_bf16(PAF(3),VFR(7),o[1],0,0,0), C1,12); \
    }while(0)
  int t=1;
  #undef CMASK
  #define CMASK(P0,P1,t) do{}while(0)
  for(;t+5<NT;t+=2){
    STEP(pB0,pB1,pA0,pA1,t,true,true,true);     WAIT_BAR(2); RESC(); ROT();
    STEP(pA0,pA1,pB0,pB1,t+1,true,true,true);   WAIT_BAR(2); RESC(); ROT();
  }
  #undef CMASK
  #define CMASK(P0,P1,t) do{int jb_=(t)-(NT-4); if(jb_>=0)cmask(P0,P1,jb_,qrel,hi);}while(0)
  #define ENDW(tt) do{ if((tt)+3<NT){WAIT_BAR(2);} else if((tt)+2<NT){WAIT_BAR(1);} else {WAIT_BAR(0);} }while(0)
  for(;t+1<NT;t+=2){
    STEP(pB0,pB1,pA0,pA1,t,(t+3<NT),(t+1<NT),(t+1<NT));       ENDW(t);   RESC(); ROT();
    STEP(pA0,pA1,pB0,pB1,t+1,(t+4<NT),(t+2<NT),(t+2<NT));     ENDW(t+1); RESC(); ROT();
  }
  STEP(pB0,pB1,pA0,pA1,NT-1,false,false,false); RESC();
  { float sacc=pB0[0]+pB0[1]; _Pragma("unroll") for(int r=2;r<16;++r)sacc+=pB0[r]; _Pragma("unroll") for(int r=0;r<16;++r)sacc+=pB1[r]; l_reg+=sacc;
    pw0=(u32x4){PKW(pB0,0),PKW(pB0,2),PKW(pB0,4),PKW(pB0,6)};pw1=(u32x4){PKW(pB0,8),PKW(pB0,10),PKW(pB0,12),PKW(pB0,14)};pw2=(u32x4){PKW(pB1,0),PKW(pB1,2),PKW(pB1,4),PKW(pB1,6)};pw3=(u32x4){PKW(pB1,8),PKW(pB1,10),PKW(pB1,12),PKW(pB1,14)};
    SBAR(); pv(o,vb0+sl_cur,PAF(0),PAF(1),PAF(2),PAF(3)); }
  #undef PKW
  #undef PAF
  #undef VFR
  #undef PIN
  #undef MX3
  #undef GAPA
  #undef GAPB
  #undef EX
  #undef VRD
  #undef KRD
  #undef STEP
  #undef ENDW
  {auto rr=__builtin_amdgcn_permlane32_swap(__float_as_uint(l_reg),__float_as_uint(l_reg),false,false);l_reg=__uint_as_float(rr[0])+__uint_as_float(rr[1]);}
  if(hi==0)wsf[32+r32]=l_reg;asm volatile("s_waitcnt lgkmcnt(0)":::"memory");
  float rli[16];
  #pragma unroll
  for(int r=0;r<16;++r)rli[r]=__builtin_amdgcn_rcpf(wsf[32+crow(r,hi)]);
  bf16*Ow=O+(rowbase+q0+wid*QBLK)*DM+h*D;
  { bf16*stg=(bf16*)(shm+LDS_OST)+wid*2048;
    #pragma unroll
    for(int r=0;r<16;++r){const int orow=crow(r,hi);
      #pragma unroll
      for(int d0=0;d0<2;++d0)stg[orow*64+d0*32+r32]=__float2bfloat16(o[d0][r]*rli[r]);}
    asm volatile("s_waitcnt lgkmcnt(0)":::"memory");
    #pragma unroll
    for(int i=0;i<4;++i){const int row=i*8+(lane>>3),ch=lane&7; const u32x4 v=*(const u32x4*)(stg+row*64+ch*8); ATTN_STORE16(Ow+(long)row*DM+ch*8,v);} }
  asm volatile("s_waitcnt lgkmcnt(0)\n\ts_barrier":::"memory");
  #undef FBINIT
  #undef DMA_K
  #undef DMA_V
  #undef CMASK
  #undef START
  #undef RESC
  #undef ROT
}
constexpr int ATTN_LDS_BYTES=LDS_BYTES;
struct AttnTensors { const bf16* Q; const bf16* K; const bf16* V; bf16* O; const float* F; const int* T0; };
struct AttnUnit { int bh; int qb; };
struct StaticOrder {
  int vcu;
  __device__ __forceinline__ explicit StaticOrder(int grid,int block):vcu((block%8)*(grid/8)+block/8){}
  __device__ __forceinline__ bool next(int i,AttnUnit&u)const{ if(i>=4)return false; const int s=vcu&7; u.bh=vcu>>3; u.qb=(i==0)?s:(i==1)?15-s:(i==2)?16+s:31-s; return true; }
  __device__ __forceinline__ void a_ready(const AttnUnit&)const{}
  __device__ __forceinline__ void done(const AttnUnit&)const{}
};
template<class Sched,int THRL=8> __device__ __forceinline__ void attn_phase(char*lds,const AttnTensors&T,const Sched&S){
  AttnUnit u;
  for(int i=0;S.next(i,u);++i){ S.a_ready(u); attn_unit<THRL>(u.bh/NHEAD,u.bh%NHEAD,u.qb,T.Q,T.K,T.V,T.O,T.F+(size_t)u.bh*SEQ,__builtin_amdgcn_readfirstlane(T.T0[u.bh*NQB+u.qb]),lds); S.done(u); }
}
#undef SBAR
#undef WAIT_BAR
}

#define LAS __attribute__((address_space(3)))
typedef unsigned short bf16;
typedef float f32x4 __attribute__((ext_vector_type(4)));
typedef float f32x2 __attribute__((ext_vector_type(2)));
typedef unsigned v4u __attribute__((ext_vector_type(4)));
typedef unsigned v2u __attribute__((ext_vector_type(2)));

constexpr int T_ = 32768, SEQ = 8192, NWAVES = 8, DFF = 2816, NIN = 7192;
constexpr float LOG2E = 1.4426950408889634f;
constexpr int LDS_BYTES = 147456;
constexpr int NPHASE = 31;
constexpr size_t MiB = (size_t)1 << 20;
constexpr size_t WS_W = 1 * MiB;
constexpr size_t W_1U = 0, W_1D = W_1U + (size_t)5632 * 1024 * 2, W_IN = W_1D + (size_t)1024 * 2816 * 2, W_G = W_IN + (size_t)4352 * 1024 * 2,
                 W_BR = W_G + (size_t)3072 * 1024 * 2, W_O = W_BR + (size_t)3 * 1024 * 512 * 2, W_2U = W_O + (size_t)1024 * 1024 * 2, W_2D = W_2U + (size_t)5632 * 1024 * 2,
                 W_PG = W_2D + (size_t)1024 * 2816 * 2, W_PP = W_PG + (size_t)1024 * 1024 * 2, W_END = W_PP + (size_t)1024 * 256 * 2;
static_assert(W_END == 55 * MiB, "weight map");
constexpr size_t WS_LW = 65536;
constexpr size_t WS_T0 = 65536 + 262144;
constexpr size_t WS_XB = 56 * MiB;
constexpr size_t WS_FC = 120 * MiB;
constexpr size_t WS_LRUS = 121 * MiB;
constexpr size_t WS_LRUC = 122 * MiB;
constexpr size_t WS_EG = 123 * MiB;
constexpr size_t WS_BIG = 124 * MiB;
constexpr size_t B_H = 0;
constexpr size_t B_AX = 0, B_GQ = 32 * MiB, B_GK = 48 * MiB, B_AY = 64 * MiB, B_GV = 96 * MiB, B_GR = 128 * MiB, B_CQ = 160 * MiB, B_CK = 192 * MiB, B_CV = 224 * MiB;
constexpr size_t B_LOW = 256 * MiB, B_FL = 258 * MiB, B_GST = 260 * MiB, B_END = 324 * MiB;
constexpr size_t B_S = 0  , B_P = 192 * MiB  , B_PB = 0  , B_S2 = 64 * MiB;
constexpr size_t WS_END = WS_BIG + B_END;

__device__ __forceinline__ float wave_sum(float v) {
#pragma unroll
    for (int o = 1; o < 64; o <<= 1) v += __shfl_xor(v, o);
    return v;
}
__device__ __forceinline__ float sigm(float x) { return __builtin_amdgcn_rcpf(1.0f + __builtin_amdgcn_exp2f(-LOG2E * x)); }
__device__ __forceinline__ float one_minus_exp(float x) {
    float p = 1.0f + x * (1.0f / 7.0f); p = 1.0f + p * x * (1.0f / 6.0f); p = 1.0f + p * x * (1.0f / 5.0f); p = 1.0f + p * x * (1.0f / 4.0f); p = 1.0f + p * x * (1.0f / 3.0f); p = 1.0f + p * x * 0.5f;
    const float small = -x * p, big = 1.0f - __expf(x);
    return x > -0.25f ? small : big;
}
__device__ __forceinline__ float log_sigmoid(float x) { return fminf(x, 0.f) - log1pf(__expf(-fabsf(x))); }
__device__ __forceinline__ float gelu_tanh(float x) { const float u = 0.7978845608028654f * (x + 0.044715f * x * x * x); return x * sigm(2.0f * u); }
__device__ __forceinline__ float bflo(unsigned w) { return __uint_as_float(w << 16); }
__device__ __forceinline__ float bfhi(unsigned w) { return __uint_as_float(w & 0xffff0000u); }
__device__ __forceinline__ float bf2f(bf16 h) { return __uint_as_float(((unsigned)h) << 16); }
__device__ __forceinline__ unsigned pk2(float lo, float hi) { return pg8::cvt_pk_bf16(lo, hi); }
__device__ __forceinline__ bf16 f2bf(float f) { return (bf16)(pk2(f, 0.f) & 0xffffu); }

__device__ __forceinline__ int tr_row(int kind, int r0, int j) { if (kind == 0) return r0 + j; const int up = j >= DFF ? 1 : 0, c = j - up * DFF; return 256 * (c >> 7) + 128 * up + (c & 127); }
__device__ __forceinline__ void tr_item(const float* W, int K, int ldn, int c0, int nc, bf16* WT, int r0, int kind, LAS float* scr, int item, int lane) {
    const int nblk = (nc + 31) >> 5, kb = item / nblk, nb = item - kb * nblk, k0 = 64 * kb, n0 = 32 * nb;
    const int cl = n0 + (lane & 31); const bool okc = cl < nc;
#pragma unroll 8
    for (int i = 0; i < 32; ++i) { const int kk = 2 * i + (lane >> 5); scr[kk * 33 + (lane & 31)] = okc ? W[(size_t)(k0 + kk) * ldn + c0 + cl] : 0.f; }
    asm volatile("s_waitcnt lgkmcnt(0)" ::: "memory");
    const int c = lane & 7;
#pragma unroll
    for (int j = 0; j < 4; ++j) { const int n = (lane >> 3) + 8 * j; const LAS float* s = scr + (8 * c) * 33 + n;
        v4u o; o.x = pk2(s[0 * 33], s[1 * 33]); o.y = pk2(s[2 * 33], s[3 * 33]); o.z = pk2(s[4 * 33], s[5 * 33]); o.w = pk2(s[6 * 33], s[7 * 33]);
        if (n0 + n < nc) *(v4u*)(WT + (size_t)tr_row(kind, r0, n0 + n) * K + k0 + 8 * c) = o; }
    asm volatile("s_waitcnt lgkmcnt(0)" ::: "memory");
}
__device__ __forceinline__ void tr_seg(const float* W, int K, int ldn, int c0, int nc, bf16* WT, int r0, int kind, LAS float* scr, int gw, int NGW, int lane, int& rot) {
    const int nblk = (nc + 31) >> 5, nit = (K >> 6) * nblk;
    int start = gw - rot; if (start < 0) start += NGW;
    for (int it = start; it < nit; it += NGW) tr_item(W, K, ldn, c0, nc, WT, r0, kind, scr, it, lane);
    rot = (rot + nit) % NGW;
}
struct Args { const float* in[31]; float* out; unsigned char* ws; int ph_lo, ph_hi; };
__device__ __forceinline__ void convert_weights(const Args& a, int z, int l, unsigned char* wsw, LAS float* scr, int gw, int NGW, int lane) {
    int rot = 0;
    tr_seg(a.in[2 + z] + (size_t)l * 1024 * 5632, 1024, 5632, 0, 5632, (bf16*)(wsw + W_1U), 0, 1, scr, gw, NGW, lane, rot);
    tr_seg(a.in[3 + z] + (size_t)l * 2816 * 1024, 2816, 1024, 0, 1024, (bf16*)(wsw + W_1D), 0, 0, scr, gw, NGW, lane, rot);
    const float* win = a.in[6 + z] + (size_t)l * 1024 * NIN; bf16* WIN = (bf16*)(wsw + W_IN);
    tr_seg(win, 1024, NIN, 0, 2048, WIN, 0, 0, scr, gw, NGW, lane, rot);
    tr_seg(win, 1024, NIN, 2064, 2048, WIN, 2048, 0, scr, gw, NGW, lane, rot);
    tr_seg(win, 1024, NIN, 2048, 16, WIN, 4096, 0, scr, gw, NGW, lane, rot);
    tr_seg(win, 1024, NIN, 4112, 8, WIN, 4112, 0, scr, gw, NGW, lane, rot);
    tr_seg(win, 1024, NIN, 4120, 3072, (bf16*)(wsw + W_G), 0, 0, scr, gw, NGW, lane, rot);
    for (int j = 0; j < 3; ++j) tr_seg(a.in[18 + z] + ((size_t)l * 3 + j) * 512 * 1024, 512, 1024, 0, 1024, (bf16*)(wsw + W_BR) + (size_t)j * 1024 * 512, 0, 0, scr, gw, NGW, lane, rot);
    tr_seg(a.in[19 + z] + (size_t)l * 1024 * 1024, 1024, 1024, 0, 1024, (bf16*)(wsw + W_O), 0, 0, scr, gw, NGW, lane, rot);
    tr_seg(a.in[22 + z] + (size_t)l * 1024 * 5632, 1024, 5632, 0, 5632, (bf16*)(wsw + W_2U), 0, 1, scr, gw, NGW, lane, rot);
    tr_seg(a.in[23 + z] + (size_t)l * 2816 * 1024, 2816, 1024, 0, 1024, (bf16*)(wsw + W_2D), 0, 0, scr, gw, NGW, lane, rot);
    tr_seg(a.in[27 + z] + (size_t)l * 1024 * 1024, 1024, 1024, 0, 1024, (bf16*)(wsw + W_PG), 0, 0, scr, gw, NGW, lane, rot);
    tr_seg(a.in[26 + z] + (size_t)l * 256 * 1024, 256, 1024, 0, 1024, (bf16*)(wsw + W_PP), 0, 0, scr, gw, NGW, lane, rot);
    {   bf16* LW = (bf16*)(wsw - WS_W + WS_LW); const float* wa = a.in[9 + z] + (size_t)l * 32768; const float* wx = a.in[11 + z] + (size_t)l * 32768;
        for (int i = gw * 64 + lane; i < 65536; i += NGW * 64) { const int cc = i & 63, dd = (i >> 6) & 63, nn = (i >> 12) & 7, mat = i >> 15; LW[i] = f2bf((mat ? wx : wa)[(nn * 64 + cc) * 64 + dd]); } }
}
__device__ __forceinline__ void ln_phase(float* X, bf16* XB, const float* g, const float* b, int gw, int NGW, int lane) {
    f32x4 gv[4], bv[4];
#pragma unroll
    for (int j = 0; j < 4; ++j) { gv[j] = *(const f32x4*)(g + 4 * lane + 256 * j); bv[j] = *(const f32x4*)(b + 4 * lane + 256 * j); }
    for (int m = gw; m < T_; m += NGW) {
        f32x4* xr = (f32x4*)(X + (size_t)m * 1024) + lane; f32x4 v[4]; float s = 0.f;
#pragma unroll
        for (int j = 0; j < 4; ++j) { v[j] = xr[64 * j]; s += (v[j].x + v[j].y) + (v[j].z + v[j].w); }
        const float mean = wave_sum(s) * (1.f / 1024.f); float s2 = 0.f;
#pragma unroll
        for (int j = 0; j < 4; ++j) { v[j] = v[j] - mean; s2 += (v[j].x * v[j].x + v[j].y * v[j].y) + (v[j].z * v[j].z + v[j].w * v[j].w); }
        const float rstd = 1.f / sqrtf(wave_sum(s2) * (1.f / 1024.f) + 1e-5f);
        v2u* o8 = (v2u*)(XB + (size_t)m * 1024) + lane;
#pragma unroll
        for (int j = 0; j < 4; ++j) { const f32x4 y = v[j] * rstd * gv[j] + bv[j]; xr[64 * j] = y; v2u w; w.x = pk2(y.x, y.y); w.y = pk2(y.z, y.w); o8[64 * j] = w; }
    }
}
__device__ __forceinline__ void cvt_rows(const float* src, bf16* dst, size_t n4, int gtid, int nthr) {
    for (size_t i = gtid; i < n4; i += nthr) { const f32x4 v = ((const f32x4*)src)[i]; v2u w; w.x = pk2(v.x, v.y); w.y = pk2(v.z, v.w); ((v2u*)dst)[i] = w; }
}
__device__ __forceinline__ void fcum_item(int bh, const float* FL, const float* bfl, float* FC, const bf16* CQ, const bf16* CK, int* T0, LAS float* sm, int tid, int lane, int wave) {
    const int b = bh >> 3, h = bh & 7; const float bfh = bfl[h];
    float v[16]; float run = 0.f;
#pragma unroll
    for (int j = 0; j < 16; ++j) { const int s = tid * 16 + j; run += log_sigmoid(FL[((size_t)(b * SEQ + s)) * 8 + h] + bfh); v[j] = run; }
    float inc = run;
#pragma unroll
    for (int o = 1; o < 64; o <<= 1) { const float t = __shfl_up(inc, o); if (lane >= o) inc += t; }
    if (lane == 63) sm[wave] = inc;
    float qn = 0.f, kn = 0.f;
#pragma unroll 2
    for (int j = 0; j < 16; ++j) { const size_t ro = ((size_t)(b * SEQ + tid * 16 + j)) * 512 + h * 64; float sq = 0.f, sk = 0.f;
#pragma unroll
        for (int c = 0; c < 8; ++c) { const v4u a = *(const v4u*)(CQ + ro + 8 * c), k = *(const v4u*)(CK + ro + 8 * c);
#pragma unroll
            for (int i = 0; i < 4; ++i) { const float a0 = bflo(a[i]), a1 = bfhi(a[i]), k0 = bflo(k[i]), k1 = bfhi(k[i]); sq += a0 * a0 + a1 * a1; sk += k0 * k0 + k1 * k1; } }
        qn = fmaxf(qn, sq); kn = fmaxf(kn, sk); }
#pragma unroll
    for (int o = 1; o < 64; o <<= 1) { qn = fmaxf(qn, __shfl_xor(qn, o)); kn = fmaxf(kn, __shfl_xor(kn, o)); }
    if (lane == 0) { sm[16 + wave] = qn; sm[32 + wave] = kn; }
    __syncthreads();
    float woff = 0.f;
#pragma unroll
    for (int w = 0; w < 8; ++w) if (w < wave) woff += sm[w];
    const float off = woff + inc - run;
    f32x4* dst = (f32x4*)(FC + (size_t)bh * SEQ + tid * 16);
#pragma unroll
    for (int j = 0; j < 4; ++j) dst[j] = (f32x4){(off + v[4 * j]) * LOG2E, (off + v[4 * j + 1]) * LOG2E, (off + v[4 * j + 2]) * LOG2E, (off + v[4 * j + 3]) * LOG2E};
    if ((tid & 3) == 3) sm[64 + (tid >> 2)] = (off + v[15]) * LOG2E;
    if ((tid & 15) == 0) sm[256 + (tid >> 4)] = (off + v[0]) * LOG2E;
    __syncthreads();
    if (tid < 32) { float qm = 0.f, km = 0.f;
#pragma unroll
        for (int w = 0; w < 8; ++w) { qm = fmaxf(qm, sm[16 + w]); km = fmaxf(km, sm[32 + w]); }
        const float thr = sm[256 + tid] + 40.0f + 2.0f * 1.01f * sqrtf(qm) * sqrtf(km); const int nt = 4 * (tid + 1); int cnt = 0;
        for (int t = 0; t < nt; ++t) cnt += (sm[64 + t] > thr) ? 1 : 0;
        cnt &= ~1; if (cnt > nt - 4) cnt = nt - 4;
        T0[bh * 32 + tid] = cnt; }
    __syncthreads();
}
typedef short lbf16x8 __attribute__((ext_vector_type(8)));
constexpr int LRU_P = 68;
template <int MODE> __device__ __forceinline__ void lru_item(int item, const bf16* AX, bf16* AY, const float* cw, const float* cb, const bf16* LW, const float* ba, const float* bx, const float* lam,
                                                            float* LRUS, const float* LRUC, LAS unsigned char* lds, int tid) {
    const int n = item & 7, c = (item >> 3) & 63, b = item >> 9;
    LAS float* XC = (LAS float*)lds;
    LAS float* RP = XC + 128 * 64;
    LAS float* IP = RP + 128 * LRU_P;
    LAS float* SG = IP + 128 * LRU_P;
    LAS bf16* XCB = (LAS bf16*)(SG + 1024);
    const int ch4 = tid & 15, tt = tid >> 4; const int chn = n * 64 + 4 * ch4;
    const int wv = tid >> 6, ln = tid & 63, fr = ln & 15, fq = ln >> 4;
    lbf16x8 wf[2][4][2];
#pragma unroll
    for (int mat = 0; mat < 2; ++mat)
#pragma unroll
        for (int n4 = 0; n4 < 4; ++n4)
#pragma unroll
            for (int ks = 0; ks < 2; ++ks) wf[mat][n4][ks] = *(const lbf16x8*)(LW + ((size_t)((mat * 8 + n) * 64 + 16 * n4 + fr)) * 64 + ks * 32 + fq * 8);
    const int d = tid & 63, seg = tid >> 6; const int chd = n * 64 + d;
    const float lm = lam[chd], bav = ba[chd], bxv = bx[chd];
    float Hin = 0.f; if (MODE == 1) Hin = LRUC[(size_t)(b * 64 + c) * 512 + chd];
    v2u ay[4];
    if (MODE == 1) {
#pragma unroll
        for (int ps = 0; ps < 4; ++ps) ay[ps] = *(const v2u*)(AY + ((size_t)(b * SEQ + c * 128 + ps * 32 + tt)) * 512 + chn);
    }
    {   f32x4 cwv[4];
#pragma unroll
        for (int k = 0; k < 4; ++k) cwv[k] = *(const f32x4*)(cw + k * 512 + chn);
        const f32x4 cbv = *(const f32x4*)(cb + chn);
        v2u xin[4][4];
#pragma unroll
        for (int ps = 0; ps < 4; ++ps)
#pragma unroll
            for (int k = 0; k < 4; ++k) { const int pos = c * 128 + ps * 32 + tt - 3 + k; xin[ps][k] = (v2u){0u, 0u}; if (pos >= 0) xin[ps][k] = *(const v2u*)(AX + ((size_t)(b * SEQ + pos)) * 512 + chn); }
#pragma unroll
        for (int ps = 0; ps < 4; ++ps) { const int t = ps * 32 + tt; f32x4 acc = cbv;
#pragma unroll
            for (int k = 0; k < 4; ++k) { const v2u w = xin[ps][k]; acc += cwv[k] * (f32x4){bflo(w.x), bfhi(w.x), bflo(w.y), bfhi(w.y)}; }
            *(LAS f32x4*)(XC + t * 64 + 4 * ch4) = acc;
            v2u pk; pk.x = pk2(acc.x, acc.y); pk.y = pk2(acc.z, acc.w); *(LAS v2u*)(XCB + t * 72 + 4 * ch4) = pk; }
    }
    __syncthreads();
    {   const int trow = 16 * wv + fr;
        lbf16x8 xf[2];
#pragma unroll
        for (int ks = 0; ks < 2; ++ks) xf[ks] = *(const LAS lbf16x8*)(XCB + trow * 72 + ks * 32 + fq * 8);
#pragma unroll
        for (int mat = 0; mat < 2; ++mat)
#pragma unroll
            for (int n4 = 0; n4 < 4; ++n4) { f32x4 acc = (f32x4){0.f, 0.f, 0.f, 0.f};
#pragma unroll
                for (int ks = 0; ks < 2; ++ks) acc = __builtin_amdgcn_mfma_f32_16x16x32_bf16(wf[mat][n4][ks], xf[ks], acc, 0, 0, 0);
                *(LAS f32x4*)((mat ? IP : RP) + trow * LRU_P + 16 * n4 + 4 * fq) = acc; }
    }
    __syncthreads();
    const float sp = fmaxf(-lm, 0.f) + log1pf(__expf(-fabsf(lm)));
    float hrun = 0.f, prun = 1.f;
#pragma unroll 4
    for (int j = 0; j < 16; ++j) { const int t = seg * 16 + j;
        const float xv = XC[t * 64 + d];
        const float r = sigm(RP[t * LRU_P + d] + bav), ig = sigm(IP[t * LRU_P + d] + bxv); const float la = -8.0f * r * sp; const float av = __expf(la); const float mult = __builtin_amdgcn_sqrtf(one_minus_exp(2.0f * la));
        hrun = av * hrun + mult * ig * xv; prun *= av;
        if (MODE == 1) { IP[t * LRU_P + d] = hrun; RP[t * LRU_P + d] = prun; } }
    SG[(seg * 64 + d) * 2] = prun; SG[(seg * 64 + d) * 2 + 1] = hrun;
    __syncthreads();
    if (MODE == 0) {
        if (seg == 0) { float A = 1.f, H = 0.f;
#pragma unroll
            for (int s = 0; s < 8; ++s) { const float p = SG[(s * 64 + d) * 2], hh = SG[(s * 64 + d) * 2 + 1]; H = p * H + hh; A *= p; }
            *(f32x2*)(LRUS + ((size_t)((b * 64 + c) * 512 + chd)) * 2) = (f32x2){A, H}; }
    } else {
#pragma unroll
        for (int s = 0; s < 8; ++s) if (s < seg) Hin = SG[(s * 64 + d) * 2] * Hin + SG[(s * 64 + d) * 2 + 1];
#pragma unroll 4
        for (int j = 0; j < 16; ++j) { const int t = seg * 16 + j; IP[t * LRU_P + d] = IP[t * LRU_P + d] + RP[t * LRU_P + d] * Hin; }
        __syncthreads();
#pragma unroll
        for (int ps = 0; ps < 4; ++ps) { const int t = ps * 32 + tt; const f32x4 h4 = *(const LAS f32x4*)(IP + t * LRU_P + 4 * ch4); const v2u w = ay[ps];
            v2u o; o.x = pk2(gelu_tanh(bflo(w.x)) * h4.x, gelu_tanh(bfhi(w.x)) * h4.y); o.y = pk2(gelu_tanh(bflo(w.y)) * h4.z, gelu_tanh(bfhi(w.y)) * h4.w);
            *(v2u*)(AY + ((size_t)(b * SEQ + c * 128 + t)) * 512 + chn) = o; }
    }
    __syncthreads();
}
__device__ __forceinline__ void gla_delta_item(int item, const bf16* GK, const bf16* GV, const float* LOW, const float* wg2, const float* bg, float* GST, float* EG, LAS unsigned char* lds, int tid) {
    const int h = item & 3, n = (item >> 2) & 127, b = item >> 9; const int row0 = b * SEQ + n * 64;
    LAS float* KD = (LAS float*)lds;
    LAS float* V = KD + 4096;
    LAS float* SEG = V + 8192;
    const int dk = tid & 63, tg = tid >> 6;
    float wv[16];
#pragma unroll
    for (int r = 0; r < 16; ++r) wv[r] = wg2[r * 256 + h * 64 + dk];
    const float bgv = bg[h * 64 + dk];
    float la[8]; float run = 0.f;
#pragma unroll
    for (int j = 0; j < 8; ++j) { const int t = tg * 8 + j; const f32x4* lr = (const f32x4*)(LOW + (size_t)(row0 + t) * 16); float z = bgv;
#pragma unroll
        for (int q = 0; q < 4; ++q) { const f32x4 x = lr[q]; z += x.x * wv[4 * q] + x.y * wv[4 * q + 1] + x.z * wv[4 * q + 2] + x.w * wv[4 * q + 3]; }
        run += log_sigmoid(z) * (1.0f / 16.0f); la[j] = run; }
    SEG[tg * 64 + dk] = run;
    {   const int t = tid >> 3, c16 = (tid & 7) * 16; const v4u* src = (const v4u*)(GV + (size_t)(row0 + t) * 512 + h * 128 + c16); const v4u a = src[0], c = src[1];
        LAS f32x4* dst = (LAS f32x4*)(V + t * 128 + c16);
        dst[0] = (f32x4){bflo(a.x), bfhi(a.x), bflo(a.y), bfhi(a.y)}; dst[1] = (f32x4){bflo(a.z), bfhi(a.z), bflo(a.w), bfhi(a.w)};
        dst[2] = (f32x4){bflo(c.x), bfhi(c.x), bflo(c.y), bfhi(c.y)}; dst[3] = (f32x4){bflo(c.z), bfhi(c.z), bflo(c.w), bfhi(c.w)}; }
    __syncthreads();
    float off = 0.f, tot = 0.f;
#pragma unroll
    for (int s = 0; s < 8; ++s) { const float x = SEG[s * 64 + dk]; tot += x; if (s < tg) off += x; }
#pragma unroll
    for (int j = 0; j < 8; ++j) { const int t = tg * 8 + j; const float kv = bf2f(GK[(size_t)(row0 + t) * 256 + h * 64 + dk]); KD[t * 64 + dk] = kv * __expf(tot - (off + la[j])); }
    if (tg == 0) EG[(size_t)item * 64 + dk] = __expf(tot);
    __syncthreads();
    const int dv4 = tid & 31, dkg = tid >> 5;
    f32x4 acc[4];
#pragma unroll
    for (int i = 0; i < 4; ++i) acc[i] = (f32x4){0.f, 0.f, 0.f, 0.f};
#pragma unroll 8
    for (int t = 0; t < 64; ++t) { const f32x4 kd = *(const LAS f32x4*)(KD + t * 64 + dkg * 4); const f32x4 vv = *(const LAS f32x4*)(V + t * 128 + dv4 * 4);
        acc[0] += vv * kd.x; acc[1] += vv * kd.y; acc[2] += vv * kd.z; acc[3] += vv * kd.w; }
#pragma unroll
    for (int i = 0; i < 4; ++i) *(f32x4*)(GST + ((size_t)item * 64 + dkg * 4 + i) * 128 + dv4 * 4) = acc[i];
    __syncthreads();
}
__device__ __forceinline__ void gla_scan(float* GST, const float* EG, int gtid, int nthr) {
    for (int g = gtid; g < 131072; g += nthr) {
        const int dv = g & 127, dk = (g >> 7) & 63, h = (g >> 13) & 3, b = g >> 15; float st = 0.f;
#pragma unroll 1
        for (int n0 = 0; n0 < 128; n0 += 8) { float dl[8], e[8];
#pragma unroll
            for (int i = 0; i < 8; ++i) { const size_t cbi = (size_t)((b * 128 + n0 + i) * 4 + h); dl[i] = GST[(cbi * 64 + dk) * 128 + dv]; e[i] = EG[cbi * 64 + dk]; }
#pragma unroll
            for (int i = 0; i < 8; ++i) { const size_t cbi = (size_t)((b * 128 + n0 + i) * 4 + h); st = e[i] * st + dl[i]; GST[(cbi * 64 + dk) * 128 + dv] = st; } }
    }
}
__device__ __forceinline__ void lru_carry(const float* LRUS, float* LRUC, int gtid) {
    if (gtid < 2048) { const int b = gtid >> 9, ch = gtid & 511; float H = 0.f;
#pragma unroll 8
        for (int c = 0; c < 64; ++c) { const size_t i = (size_t)(b * 64 + c) * 512 + ch; LRUC[i] = H; const f32x2 s = *(const f32x2*)(LRUS + i * 2); H = s.x * H + s.y; } }
}
__device__ __forceinline__ void gla_out_item(int item, const bf16* GQ, bf16* GR, const float* GST, const float* ng, LAS unsigned char* lds, int tid) {
    const int h = item & 3, np = (item >> 2) & 63, b = item >> 8;
    const int half = tid >> 8, lt = tid & 255; const int n = np * 2 + half; const int row0 = b * SEQ + n * 64;
    LAS float* QT = (LAS float*)lds + half * (4096 + 8192);
    LAS float* ST = QT + 4096;
    {   const int t = lt >> 2, d0 = (lt & 3) * 16; const v4u* src = (const v4u*)(GQ + (size_t)(row0 + t) * 256 + h * 64 + d0); const v4u a = src[0], c = src[1];
#pragma unroll
        for (int i = 0; i < 4; ++i) { QT[(d0 + 2 * i) * 64 + t] = bflo(a[i]); QT[(d0 + 2 * i + 1) * 64 + t] = bfhi(a[i]); QT[(d0 + 8 + 2 * i) * 64 + t] = bflo(c[i]); QT[(d0 + 8 + 2 * i + 1) * 64 + t] = bfhi(c[i]); }
        const f32x4* ss = (const f32x4*)(GST + ((size_t)((b * 128 + n) * 4 + h)) * 8192);
#pragma unroll
        for (int i = 0; i < 8; ++i) ((LAS f32x4*)ST)[lt + 256 * i] = ss[lt + 256 * i]; }
    __syncthreads();
    const int dv4 = lt & 31, tg = lt >> 5;
    f32x4 acc[8];
#pragma unroll
    for (int i = 0; i < 8; ++i) acc[i] = (f32x4){0.f, 0.f, 0.f, 0.f};
#pragma unroll 4
    for (int dk = 0; dk < 64; ++dk) { const f32x4 s = *(const LAS f32x4*)(ST + dk * 128 + dv4 * 4); const f32x4 qa = *(const LAS f32x4*)(QT + dk * 64 + tg * 8), qb = *(const LAS f32x4*)(QT + dk * 64 + tg * 8 + 4);
        acc[0] += s * qa.x; acc[1] += s * qa.y; acc[2] += s * qa.z; acc[3] += s * qa.w; acc[4] += s * qb.x; acc[5] += s * qb.y; acc[6] += s * qb.z; acc[7] += s * qb.w; }
    const f32x4 g = *(const f32x4*)(ng + h * 128 + dv4 * 4);
#pragma unroll
    for (int j = 0; j < 8; ++j) { const f32x4 o = acc[j]; float ss = (o.x * o.x + o.y * o.y) + (o.z * o.z + o.w * o.w);
        ss += __shfl_xor(ss, 1); ss += __shfl_xor(ss, 2); ss += __shfl_xor(ss, 4); ss += __shfl_xor(ss, 8); ss += __shfl_xor(ss, 16);
        const float rs = 1.0f / sqrtf(ss * (1.0f / 128.0f) + 1e-6f);
        v2u* p = (v2u*)(GR + (size_t)(row0 + tg * 8 + j) * 512 + h * 128 + dv4 * 4); const v2u rv = *p;
        const float r0 = bflo(rv.x), r1 = bfhi(rv.x), r2 = bflo(rv.y), r3 = bfhi(rv.y);
        v2u w; w.x = pk2(o.x * rs * g.x * (r0 * sigm(r0)), o.y * rs * g.y * (r1 * sigm(r1))); w.y = pk2(o.z * rs * g.z * (r2 * sigm(r2)), o.w * rs * g.w * (r3 * sigm(r3))); *p = w; }
    __syncthreads();
}

#ifndef MK_MULTI
#define MK_MULTI 1
#endif
#define PH_ON(k) (ONLY < 0 || ONLY == (k))
#ifndef MK_SUB
#define MK_SUB -1
#endif
#define SUB_ON(k) (MK_SUB < 0 || MK_SUB == (k))
template <int ONLY> __device__ __forceinline__ void phase_body(const Args& args, const int ph, unsigned char* lds) {
    {
        int z = 0; asm volatile("" : "+s"(z));
        int tid = threadIdx.x; asm volatile("" : "+v"(tid));
        const int lane = tid & 63, wave = __builtin_amdgcn_readfirstlane(tid >> 6);
        const int G = gridDim.x + z, bx = blockIdx.x + z;
        const int gw = bx * NWAVES + wave, NGW = G * NWAVES, gtid = bx * (NWAVES * 64) + tid, nthr = G * NWAVES * 64;
        LAS unsigned char* l3 = (LAS unsigned char*)lds + z;
        LAS float* scr = (LAS float*)(l3 + wave * 16384);
        unsigned char* ws = args.ws + z; unsigned char* wsw = ws + WS_W; unsigned char* big = ws + WS_BIG;
        float* X = args.out + z; bf16* XB = (bf16*)(ws + WS_XB);
        if (PH_ON(100) && ph == 0) {
            convert_weights(args, z, 0, wsw, scr, gw, NGW, lane);
            const f32x4* xs = (const f32x4*)args.in[(0) + z];
            for (size_t i = gtid; i < (size_t)T_ * 256; i += nthr) { const f32x4 v = xs[i]; ((f32x4*)X)[i] = v; v2u w; w.x = pk2(v.x, v.y); w.y = pk2(v.z, v.w); ((v2u*)XB)[i] = w; }
        } else {
            const int q = ph - 1, l = q / 15, s = q - l * 15;
            if (PH_ON(0) && (s == 0 || s == 10)) {
                pg8::Gemm g{XB, (const bf16*)(wsw + (s == 0 ? W_1U : W_2U)), T_, 5632, 1024}; pg8::StaticOrder S; S.init(T_, 5632, G, bx);
                pg8::EpiSwiglu E{(bf16*)(big + B_H), DFF};
                pg8::gemm_phase<pg8::EpiSwiglu, pg8::StaticOrder, PG8_ALIGN, PG8_SP2>(l3, g, S, E);
            } else if (PH_ON(1) && (s == 1 || s == 11 || s == 8)) {
#ifdef MK_DBG_A
                const bf16* A = (s == 8) ? (const bf16*)(big + MK_DBG_A) : (const bf16*)(big + B_H);
#else
                const bf16* A = (s == 8) ? (const bf16*)(big + B_P) : (const bf16*)(big + B_H);
#endif
                const bf16* Bt = (const bf16*)(wsw + (s == 1 ? W_1D : (s == 11 ? W_2D : W_O)));
                pg8::Gemm g{A, Bt, T_, 1024, (s == 8) ? 1024 : DFF}; pg8::StaticOrder S; S.init(T_, 1024, G, bx);
                pg8::EpiResid E{X, (s == 8) ? 1.0f : 0.5f};
                pg8::gemm_phase<pg8::EpiResid, pg8::StaticOrder, PG8_ALIGN, PG8_SP2>(l3, g, S, E);
            } else if (PH_ON(2) && (s == 2 || s == 9 || s == 12 || s == 14)) {
                const int gi = (s == 2) ? 4 : (s == 9 ? 20 : (s == 12 ? 24 : 29));
                ln_phase(X, XB, args.in[(gi) + z] + (size_t)l * 1024, args.in[(gi + 1) + z] + (size_t)l * 1024, gw, NGW, lane);
                if (s == 12) cvt_rows(args.in[(1) + z] + (size_t)l * T_ * 256, (bf16*)(big + B_PB), (size_t)T_ * 64, gtid, nthr);
                if (s == 14 && l == 0) convert_weights(args, z, 1, wsw, scr, gw, NGW, lane);
            } else if (PH_ON(3) && s == 3) {
                pg8::Gemm g{XB, (const bf16*)(wsw + W_IN), T_, 4352, 1024}; pg8::StaticOrder S; S.init(T_, 4352, G, bx);
                pg8::EpiMixIn E{(bf16*)big, (float*)(big + B_LOW), (float*)(big + B_FL), attn_body::C2};
                pg8::gemm_phase<pg8::EpiMixIn, pg8::StaticOrder, PG8_ALIGN, PG8_SP2>(l3, g, S, E);
            } else if (PH_ON(4) && s == 4) {
                if (bx < 32) fcum_item(bx, (const float*)(big + B_FL), args.in[(17) + z] + l * 8, (float*)(ws + WS_FC), (const bf16*)(big + B_CQ), (const bf16*)(big + B_CK), (int*)(ws + WS_T0), (LAS float*)l3, tid, lane, wave);
                for (int it = bx; it < 2048; it += G)
                    lru_item<0>(it, (const bf16*)(big + B_AX), (bf16*)(big + B_AY), args.in[(7) + z] + (size_t)l * 2048, args.in[(8) + z] + l * 512, (const bf16*)(ws + WS_LW), args.in[(10) + z] + l * 512,
                                args.in[(12) + z] + l * 512, args.in[(13) + z] + l * 512, (float*)(ws + WS_LRUS), (const float*)(ws + WS_LRUC), l3, tid);
                for (int it = bx; it < 2048; it += G)
                    gla_delta_item(it, (const bf16*)(big + B_GK), (const bf16*)(big + B_GV), (const float*)(big + B_LOW), args.in[(14) + z] + (size_t)l * 4096, args.in[(15) + z] + l * 256,
                                   (float*)(big + B_GST), (float*)(ws + WS_EG), l3, tid);
            } else if (PH_ON(5) && s == 5) {
                gla_scan((float*)(big + B_GST), (const float*)(ws + WS_EG), gtid, nthr);
                lru_carry((const float*)(ws + WS_LRUS), (float*)(ws + WS_LRUC), gtid);
            } else if (PH_ON(6) && s == 6) {
                const attn_body::AttnTensors AT{(const attn_body::bf16*)(big + B_CQ), (const attn_body::bf16*)(big + B_CK), (const attn_body::bf16*)(big + B_CV), (attn_body::bf16*)(big + B_CQ), (const float*)(ws + WS_FC), (const int*)(ws + WS_T0)};
                const attn_body::StaticOrder S(G, bx);
                if (SUB_ON(1)) attn_body::attn_phase<attn_body::StaticOrder>((char*)lds, AT, S);
#ifdef MK_TS
                if (bx == 0 && tid == 0) ((unsigned long long*)ws)[40 + l] = __builtin_amdgcn_s_memrealtime();
#endif
                if (SUB_ON(2)) for (int it = bx; it < 2048; it += G)
                    lru_item<1>(it, (const bf16*)(big + B_AX), (bf16*)(big + B_AY), args.in[(7) + z] + (size_t)l * 2048, args.in[(8) + z] + l * 512, (const bf16*)(ws + WS_LW), args.in[(10) + z] + l * 512,
                                args.in[(12) + z] + l * 512, args.in[(13) + z] + l * 512, (float*)(ws + WS_LRUS), (const float*)(ws + WS_LRUC), l3, tid);
#ifdef MK_TS
                if (bx == 0 && tid == 0) ((unsigned long long*)ws)[42 + l] = __builtin_amdgcn_s_memrealtime();
#endif
                if (SUB_ON(3)) for (int it = bx; it < 1024; it += G)
                    gla_out_item(it, (const bf16*)(big + B_GQ), (bf16*)(big + B_GR), (const float*)(big + B_GST), args.in[(16) + z] + l * 512, l3, tid);
            } else if (PH_ON(7) && s == 7) {
#pragma unroll 1
                for (int j = 0; j < 3; ++j) {
#ifdef MK_DBG_BR
                    if (j != MK_DBG_BR) continue;
#endif
                    {
#ifdef MK_DBG_WG
                        pg8::Gemm g{XB, (const bf16*)(wsw + W_O), T_, 1024, 1024};
#else
                        pg8::Gemm g{XB, (const bf16*)(wsw + W_G) + (size_t)j * 1024 * 1024, T_, 1024, 1024};
#endif
                         pg8::StaticOrder S; S.init(T_, 1024, G, bx);
                        pg8::EpiSig E{(bf16*)(big + B_S), nullptr};
                        pg8::gemm_phase<pg8::EpiSig, pg8::StaticOrder, PG8_ALIGN, PG8_SP2>(l3, g, S, E); }
#ifdef MK_DBG_FENCE
                    asm volatile("s_waitcnt vmcnt(0)" ::: "memory"); __builtin_amdgcn_fence(__ATOMIC_RELEASE, "agent"); __builtin_amdgcn_fence(__ATOMIC_ACQUIRE, "agent"); __syncthreads();
#endif
#ifdef MK_DBG_SKIPB
                    if (z == 0) continue;
#endif
                    {   const bf16* Y = (const bf16*)(big + (j == 0 ? B_AY : (j == 1 ? B_GR : B_CQ)));
                        pg8::Gemm g{Y, (const bf16*)(wsw + W_BR) + (size_t)j * 1024 * 512, T_, 1024, 512}; pg8::StaticOrder S; S.init(T_, 1024, G, bx);
                        #ifdef MK_DBG_BR
                        pg8::EpiGateMul E{(const bf16*)(big + B_S), (bf16*)(big + B_P), 1};
#else
                        pg8::EpiGateMul E{(const bf16*)(big + B_S), (bf16*)(big + B_P), j == 0 ? 1 : 0};
#endif
                        pg8::gemm_phase<pg8::EpiGateMul, pg8::StaticOrder, PG8_ALIGN, PG8_SP2>(l3, g, S, E); }
                }
            } else if (PH_ON(13) && s == 13) {
                if (SUB_ON(1)) {   pg8::Gemm g{XB, (const bf16*)(wsw + W_PG), T_, 1024, 1024}; pg8::StaticOrder S; S.init(T_, 1024, G, bx);
                    pg8::EpiSig E{(bf16*)(big + B_S2), args.in[(28) + z] + (size_t)l * 1024};
                    pg8::gemm_phase<pg8::EpiSig, pg8::StaticOrder, PG8_ALIGN, PG8_SP2>(l3, g, S, E); }
                if (SUB_ON(2)) {   pg8::Gemm g{(const bf16*)(big + B_PB), (const bf16*)(wsw + W_PP), T_, 1024, 256}; pg8::StaticOrder S; S.init(T_, 1024, G, bx);
                    pg8::EpiPle E{(const bf16*)(big + B_S2), X};
                    pg8::gemm_phase<pg8::EpiPle, pg8::StaticOrder, PG8_ALIGN, PG8_SP2>(l3, g, S, E); }
            }
        }
    }
}
template <int ONLY> __global__ void __launch_bounds__(NWAVES * 64, 2) mk_fwd(Args args) {
    extern __shared__ __attribute__((aligned(16))) unsigned char lds[];
    phase_body<ONLY>(args, args.ph_lo, lds);
}
#if !MK_MULTI
#ifdef MK_TS
#define PHS(kind, ph) phase_body<kind>(args, ph, lds); grid.sync(); if (blockIdx.x == 0 && threadIdx.x == 0) ((unsigned long long*)args.ws)[(ph) + 1] = __builtin_amdgcn_s_memrealtime();
#else
#define PHS(kind, ph) phase_body<kind>(args, ph, lds); grid.sync();
#endif
#define LAYER(b) PHS(0, b + 0) PHS(1, b + 1) PHS(2, b + 2) PHS(3, b + 3) PHS(4, b + 4) PHS(5, b + 5) PHS(6, b + 6) PHS(7, b + 7) PHS(1, b + 8) PHS(2, b + 9) PHS(0, b + 10) PHS(1, b + 11) PHS(2, b + 12) PHS(13, b + 13)
__global__ void __launch_bounds__(NWAVES * 64, 2) mk_fused(Args args) {
    extern __shared__ __attribute__((aligned(16))) unsigned char lds[];
    cg::grid_group grid = cg::this_grid();
#ifdef MK_TS
    if (blockIdx.x == 0 && threadIdx.x == 0) ((unsigned long long*)args.ws)[0] = __builtin_amdgcn_s_memrealtime();
#endif
    PHS(100, 0)
    LAYER(1) PHS(2, 15)
    LAYER(16) phase_body<2>(args, 30, lds);
#ifdef MK_TS
    grid.sync();
    if (blockIdx.x == 0 && threadIdx.x == 0) ((unsigned long long*)args.ws)[31] = __builtin_amdgcn_s_memrealtime();
    __threadfence(); grid.sync();
    {
        const volatile unsigned long long* ts = (const volatile unsigned long long*)args.ws; float t1 = 0.f, t2 = 0.f;
        for (int k = 0; k < 31; ++k) { const float d = (float)(ts[k + 1] - ts[k]) * 0.01f; if ((MK_TS1 >> k) & 1ull) t1 += d; if ((MK_TS2 >> k) & 1ull) t2 += d; }
#ifdef MK_TS_ATT
        t1 = (float)((ts[40] - ts[7]) + (ts[41] - ts[22])) * 0.01f;
#endif
#ifdef MK_TS_LRU
        t1 = (float)((ts[42] - ts[40]) + (ts[43] - ts[41])) * 0.01f;
#endif
        const int gt = blockIdx.x * 512 + threadIdx.x;
        for (int i = gt; i < (1 << 24); i += 256 * 512) args.out[i] += t1 * 5e-6f + t2 * 0.f;
    }
#endif
}
#endif

template <int K> static bool mk_prep() { return hipFuncSetAttribute((const void*)mk_fwd<K>, hipFuncAttributeMaxDynamicSharedMemorySize, LDS_BYTES) == hipSuccess; }
extern "C" void kernel_launch(void* const* d_in, const int* in_sizes, int n_in, void* d_out, int out_size, void* d_ws, size_t ws_size, hipStream_t stream) {
    static int grid = 0;
    if (grid == 0) {
        if (n_in != 31 || in_sizes[0] != T_ * 1024 || out_size != T_ * 1024 || ws_size < WS_END) { fprintf(stderr, "kernel_launch: unexpected problem (n_in %d, out %d, ws %zu < %zu); nothing launched\n", n_in, out_size, ws_size, (size_t)WS_END); grid = -1; return; }
        int dev = 0, cus = 0;
        if (hipGetDevice(&dev) != hipSuccess || hipDeviceGetAttribute(&cus, hipDeviceAttributeMultiprocessorCount, dev) != hipSuccess) { grid = -1; return; }
#if MK_MULTI
        const bool ok = mk_prep<100>() && mk_prep<0>() && mk_prep<1>() && mk_prep<2>() && mk_prep<3>() && mk_prep<4>() && mk_prep<5>() && mk_prep<6>() && mk_prep<7>() && mk_prep<13>();
#else
        const bool ok = hipFuncSetAttribute((const void*)mk_fused, hipFuncAttributeMaxDynamicSharedMemorySize, LDS_BYTES) == hipSuccess;
#endif
        if (!ok) { fprintf(stderr, "kernel_launch: hipFuncSetAttribute failed\n"); grid = -1; return; }
        (void)hipGetLastError();
        grid = cus;
        if (grid != 256) { fprintf(stderr, "kernel_launch: built for 256 CUs, found %d; nothing launched\n", cus); grid = -1; return; }
    }
    if (grid < 0) return;
#ifdef MK_DBG_MEMSET
    hipMemsetAsync(d_ws, 0, WS_END, stream);
#endif
    Args a{};
    for (int i = 0; i < 31; ++i) a.in[i] = (const float*)d_in[i];
    a.out = (float*)d_out; a.ws = (unsigned char*)d_ws;
#if MK_MULTI
#ifndef MK_STOP
#define MK_STOP NPHASE
#endif
    for (int ph = 0; ph < MK_STOP; ++ph) { a.ph_lo = ph; a.ph_hi = ph + 1;
        const int s = ph == 0 ? -1 : (ph - 1) % 15; const dim3 g(grid), b(NWAVES * 64);
        if (s < 0) hipLaunchKernelGGL(mk_fwd<100>, g, b, LDS_BYTES, stream, a);
        else if (s == 0 || s == 10) hipLaunchKernelGGL(mk_fwd<0>, g, b, LDS_BYTES, stream, a);
        else if (s == 1 || s == 11 || s == 8) hipLaunchKernelGGL(mk_fwd<1>, g, b, LDS_BYTES, stream, a);
        else if (s == 2 || s == 9 || s == 12 || s == 14) hipLaunchKernelGGL(mk_fwd<2>, g, b, LDS_BYTES, stream, a);
        else if (s == 3) hipLaunchKernelGGL(mk_fwd<3>, g, b, LDS_BYTES, stream, a);
        else if (s == 4) hipLaunchKernelGGL(mk_fwd<4>, g, b, LDS_BYTES, stream, a);
        else if (s == 5) hipLaunchKernelGGL(mk_fwd<5>, g, b, LDS_BYTES, stream, a);
        else if (s == 6) hipLaunchKernelGGL(mk_fwd<6>, g, b, LDS_BYTES, stream, a);
        else if (s == 7) hipLaunchKernelGGL(mk_fwd<7>, g, b, LDS_BYTES, stream, a);
        else hipLaunchKernelGGL(mk_fwd<13>, g, b, LDS_BYTES, stream, a); }
#else
    a.ph_lo = 0; a.ph_hi = NPHASE; void* kargs[] = {&a};
    hipError_t e = hipLaunchCooperativeKernel((const void*)mk_fused, dim3(grid), dim3(NWAVES * 64), kargs, LDS_BYTES, stream);
    if (e != hipSuccess) fprintf(stderr, "kernel_launch: cooperative launch failed: %s\n", hipGetErrorString(e));
#endif
}
```
